# Optimizing an MI355X kernel written in HIP

```python
import math
import jax
import jax.numpy as jnp
from jax import lax
import numpy as np

D_MODEL = 2048
BATCH = 4
SEQ = 2048
DEPTH = 1
DEC_BATCH = 128
DEC_SEQ = 8
PAST_LEN = 16384
PAGE_SIZE = 128

N_META = 16
EPS = 1e-6
SSD_INNER = D_MODEL
SSD_HEADDIM = 64
SSD_HEADS = SSD_INNER // SSD_HEADDIM
SSD_GROUPS = 4
SSD_STATE = 128
SSD_CONV = 4
SSD_CHUNK = 128
SSD_CONV_DIM = SSD_INNER + 2 * SSD_GROUPS * SSD_STATE
POOL_WIDTH = D_MODEL
POOL_WINDOWS = (2, 4, 8, 16)
POOL_GROUPS = 4
POOL_GROUP_WIDTH = POOL_WIDTH // POOL_GROUPS
POOL_MAX = 16
N_BRANCH = 2
OFF_Z_SSD = 0
OFF_XBC = OFF_Z_SSD + SSD_INNER
OFF_DT = OFF_XBC + SSD_CONV_DIM
OFF_Z_POOL = OFF_DT + SSD_HEADS
OFF_U_POOL = OFF_Z_POOL + POOL_WIDTH
OFF_GATES = OFF_U_POOL + POOL_WIDTH
D_IN_PROJ = OFF_GATES + N_BRANCH * D_MODEL

kernel_name = "hybrid_ssd_pool_gated_decode_step"


def rms_norm(x, w):
    xf = x.astype(jnp.float32)
    xf = xf * lax.rsqrt(jnp.mean(xf * xf, axis=-1, keepdims=True) + EPS)
    return (xf * w.astype(jnp.float32)).astype(x.dtype)


def causal_dwconv(xbc, hist, w, b):
    ext = jnp.concatenate([hist.astype(xbc.dtype), xbc], axis=1)
    l = xbc.shape[1]
    acc = b
    for k in range(SSD_CONV):
        acc = acc + ext[:, k:k + l] * w[k]
    return jax.nn.silu(acc), ext[:, ext.shape[1] - (SSD_CONV - 1):]


def ssd_segment(x, dt, a, bm, cm, h0, q):
    bsz, l, n_h, p = x.shape
    g, n = bm.shape[2], bm.shape[3]
    r = n_h // g
    nc = l // q
    xr = x.reshape(bsz, nc, q, g, r, p)
    dtr = dt.reshape(bsz, nc, q, g, r)
    br = bm.reshape(bsz, nc, q, g, n)
    cr = cm.reshape(bsz, nc, q, g, n)
    a_cum = jnp.cumsum(dtr * a.reshape(g, r), axis=2)
    xdt = xr * dtr[..., None]
    causal = jnp.tril(jnp.ones((q, q), dtype=bool))
    seg = a_cum[:, :, :, None] - a_cum[:, :, None, :]
    decay = jnp.exp(jnp.where(causal[:, :, None, None], seg, -jnp.inf))
    cb = jnp.einsum('bctgn,bcsgn->bctsg', cr, br)
    y_diag = jnp.einsum('bctsg,bctsgr,bcsgrp->bctgrp', cb, decay, xdt)
    decay_end = jnp.exp(a_cum[:, :, -1:] - a_cum)
    chunk_states = jnp.einsum('bcsgn,bcsgr,bcsgrp->bcgrpn', br, decay_end, xdt)
    chunk_decay = jnp.exp(a_cum[:, :, -1])

    def step(h, inp):
        s_c, d_c = inp
        return h * d_c[..., None, None] + s_c, h

    h_final, h_in = lax.scan(step, h0.reshape(bsz, g, r, p, n),
                             (jnp.moveaxis(chunk_states, 1, 0), jnp.moveaxis(chunk_decay, 1, 0)))
    h_in = jnp.moveaxis(h_in, 0, 1)
    y_off = jnp.einsum('bctgn,bctgr,bcgrpn->bctgrp', cr, jnp.exp(a_cum), h_in)
    y = (y_diag + y_off).reshape(bsz, l, n_h, p)
    return y, h_final.reshape(bsz, n_h, p, n)


def pool_means(ext, n_new, first_pos):
    bsz, tot, c = ext.shape
    p = tot - n_new
    s = jnp.concatenate([jnp.zeros((bsz, POOL_MAX, c), jnp.float32),
                         jnp.cumsum(ext.astype(jnp.float32), axis=1)], axis=1)
    pos = first_pos + jnp.arange(n_new) + 1
    outs = []
    for gi, w in enumerate(POOL_WINDOWS):
        cs = slice(gi * POOL_GROUP_WIDTH, (gi + 1) * POOL_GROUP_WIDTH)
        upper = s[:, p + POOL_MAX:p + POOL_MAX + n_new, cs]
        lower = s[:, p + POOL_MAX - w:p + POOL_MAX - w + n_new, cs]
        count = jnp.minimum(w, pos).astype(jnp.float32)
        outs.append((upper - lower) / count[None, :, None])
    return jnp.concatenate(outs, axis=-1).astype(ext.dtype)


def mixer_layer(h, conv_hist, ssm_h0, pool_hist, first_pos, segments, lp):
    (norm_w, w_in, conv_w, conv_b, dt_bias, a_log, d_skip, ssd_norm_w, w_proj_ssd,
     pool_mix_w, pool_mix_b, pool_scale, w_proj_pool, w_out) = lp
    f32 = jnp.float32
    bsz, l, _ = h.shape
    xn = rms_norm(h, norm_w)
    proj = jnp.einsum('bld,de->ble', xn, w_in)
    z_ssd = proj[..., OFF_Z_SSD:OFF_XBC]
    xbc = proj[..., OFF_XBC:OFF_DT]
    dt_raw = proj[..., OFF_DT:OFF_Z_POOL]
    z_pool = proj[..., OFF_Z_POOL:OFF_U_POOL]
    u = proj[..., OFF_U_POOL:OFF_GATES]
    gate_ssd = jax.nn.sigmoid(proj[..., OFF_GATES:OFF_GATES + D_MODEL])
    gate_pool = jax.nn.sigmoid(proj[..., OFF_GATES + D_MODEL:D_IN_PROJ])

    xbc_act, conv_new = causal_dwconv(xbc, conv_hist, conv_w, conv_b)
    xbc_act = xbc_act.astype(f32)
    nb = SSD_GROUPS * SSD_STATE
    xs = xbc_act[..., :SSD_INNER].reshape(bsz, l, SSD_HEADS, SSD_HEADDIM)
    b_ssm = xbc_act[..., SSD_INNER:SSD_INNER + nb].reshape(bsz, l, SSD_GROUPS, SSD_STATE)
    c_ssm = xbc_act[..., SSD_INNER + nb:].reshape(bsz, l, SSD_GROUPS, SSD_STATE)
    dt = jax.nn.softplus(dt_raw.astype(f32) + dt_bias.astype(f32))
    a = -jnp.exp(a_log.astype(f32))
    state = ssm_h0.astype(f32)
    ys = []
    start = 0
    for seg_len, q in segments:
        sl = slice(start, start + seg_len)
        y_seg, state = ssd_segment(xs[:, sl], dt[:, sl], a, b_ssm[:, sl], c_ssm[:, sl], state, q)
        ys.append(y_seg)
        start += seg_len
    y = jnp.concatenate(ys, axis=1) + xs * d_skip.astype(f32)[:, None]
    y = y.reshape(bsz, l, SSD_INNER) * jax.nn.silu(z_ssd.astype(f32))
    yg = y.reshape(bsz, l, SSD_GROUPS, SSD_INNER // SSD_GROUPS)
    yg = yg * lax.rsqrt(jnp.mean(yg * yg, axis=-1, keepdims=True) + EPS)
    y = (yg.reshape(bsz, l, SSD_INNER) * ssd_norm_w.astype(f32)).astype(h.dtype)
    branch_ssd = y @ w_proj_ssd

    pool_ext = jnp.concatenate([pool_hist.astype(u.dtype), u], axis=1)
    means = pool_means(pool_ext, l, first_pos)
    pooled = (means - u).reshape(bsz, l, POOL_GROUPS, POOL_GROUP_WIDTH)
    mixed = jnp.einsum('blgc,gcd->blgd', pooled, pool_mix_w) + pool_mix_b
    p_out = mixed.reshape(bsz, l, POOL_WIDTH) * pool_scale * jax.nn.silu(z_pool)
    branch_pool = p_out @ w_proj_pool

    merged = gate_ssd * branch_ssd + gate_pool * branch_pool
    h_new = h + merged @ w_out
    pool_new = pool_ext[:, pool_ext.shape[1] - (POOL_MAX - 1):]
    return (h_new, conv_new.astype(conv_hist.dtype), state.astype(ssm_h0.dtype),
            pool_new.astype(pool_hist.dtype))


def setup_inputs(seed: int = 0) -> dict:
    key = jax.random.key(seed)
    ks = jax.random.split(key, 24)
    f32 = jnp.float32

    def nrm(k, shape, scale):
        return scale * jax.random.normal(k, shape, f32)

    dt0 = jnp.exp(jax.random.uniform(ks[10], (DEPTH, SSD_HEADS), f32, math.log(1e-3), math.log(1e-1)))
    return {
        "x_prompt": nrm(ks[0], (BATCH, SEQ, D_MODEL), 1.0),
        "x_sample": nrm(ks[1], (DEC_BATCH, DEC_SEQ, D_MODEL), 1.0),
        "state_conv": nrm(ks[2], (DEPTH, DEC_BATCH, SSD_CONV - 1, SSD_CONV_DIM), 1.0),
        "state_ssm": nrm(ks[3], (DEPTH, DEC_BATCH, SSD_HEADS, SSD_HEADDIM, SSD_STATE), 0.1),
        "state_pool": nrm(ks[4], (DEPTH, DEC_BATCH, POOL_MAX - 1, POOL_WIDTH), 1.0),
        "meta_tokens": nrm(ks[5], (N_META, D_MODEL), 1.0),
        "norm_w": 1.0 + nrm(ks[6], (DEPTH, D_MODEL), 0.02),
        "w_in": nrm(ks[7], (DEPTH, D_MODEL, D_IN_PROJ), D_MODEL ** -0.5),
        "conv_w": nrm(ks[8], (DEPTH, SSD_CONV, SSD_CONV_DIM), SSD_CONV ** -0.5),
        "conv_b": nrm(ks[9], (DEPTH, SSD_CONV_DIM), 0.01),
        "dt_bias": dt0 + jnp.log(-jnp.expm1(-dt0)),
        "a_log": jnp.log(jax.random.uniform(ks[11], (DEPTH, SSD_HEADS), f32, 1.0, 16.0)),
        "d_skip": 1.0 + nrm(ks[12], (DEPTH, SSD_HEADS), 0.02),
        "ssd_norm_w": 1.0 + nrm(ks[13], (DEPTH, SSD_INNER), 0.02),
        "w_proj_ssd": nrm(ks[14], (DEPTH, SSD_INNER, D_MODEL), SSD_INNER ** -0.5),
        "pool_mix_w": nrm(ks[15], (DEPTH, POOL_GROUPS, POOL_GROUP_WIDTH, POOL_GROUP_WIDTH), POOL_GROUP_WIDTH ** -0.5),
        "pool_mix_b": nrm(ks[16], (DEPTH, POOL_GROUPS, POOL_GROUP_WIDTH), 0.01),
        "pool_scale": 1.0 + nrm(ks[17], (DEPTH, POOL_WIDTH), 0.02),
        "w_proj_pool": nrm(ks[18], (DEPTH, POOL_WIDTH, D_MODEL), POOL_WIDTH ** -0.5),
        "w_out": nrm(ks[19], (DEPTH, D_MODEL, D_MODEL), D_MODEL ** -0.5),
        "final_norm_w": 1.0 + nrm(ks[20], (D_MODEL,), 0.02),
    }


def reference(x_prompt, x_sample, state_conv, state_ssm, state_pool, meta_tokens, norm_w, w_in,
              conv_w, conv_b, dt_bias, a_log, d_skip, ssd_norm_w, w_proj_ssd, pool_mix_w,
              pool_mix_b, pool_scale, w_proj_pool, w_out, final_norm_w):
    n_b, seq, _ = x_prompt.shape
    dec_seq = x_sample.shape[1]
    meta = jnp.broadcast_to(meta_tokens[None].astype(x_prompt.dtype), (n_b, N_META, D_MODEL))
    h_p = jnp.concatenate([meta, x_prompt], axis=1)
    h_s = x_sample
    seg_p = ((N_META, N_META), (seq, SSD_CHUNK))
    seg_s = ((dec_seq, dec_seq),)
    conv_p, ssm_p, pool_p, conv_s, ssm_s, pool_s = [], [], [], [], [], []
    for layer in range(DEPTH):
        lp = (norm_w[layer], w_in[layer], conv_w[layer], conv_b[layer], dt_bias[layer], a_log[layer],
              d_skip[layer], ssd_norm_w[layer], w_proj_ssd[layer], pool_mix_w[layer], pool_mix_b[layer],
              pool_scale[layer], w_proj_pool[layer], w_out[layer])
        h_p, c_new, s_new, q_new = mixer_layer(
            h_p,
            jnp.zeros((n_b, SSD_CONV - 1, SSD_CONV_DIM), state_conv.dtype),
            jnp.zeros((n_b, SSD_HEADS, SSD_HEADDIM, SSD_STATE), state_ssm.dtype),
            jnp.zeros((n_b, 0, POOL_WIDTH), state_pool.dtype),
            0, seg_p, lp)
        conv_p.append(c_new)
        ssm_p.append(s_new)
        pool_p.append(q_new)
        h_s, c_new, s_new, q_new = mixer_layer(
            h_s, state_conv[layer], state_ssm[layer], state_pool[layer], PAST_LEN, seg_s, lp)
        conv_s.append(c_new)
        ssm_s.append(s_new)
        pool_s.append(q_new)
    y_prompt = rms_norm(h_p, final_norm_w)[:, N_META:]
    y_sample = rms_norm(h_s, final_norm_w)
    new_conv_prompt = jnp.stack(conv_p)
    new_ssm_prompt = jnp.stack(ssm_p)
    new_pool_prompt = jnp.stack(pool_p)
    new_conv_sample = jnp.stack(conv_s)
    new_ssm_sample = jnp.stack(ssm_s)
    new_pool_sample = jnp.stack(pool_s)
    return (y_prompt, y_sample, new_conv_prompt, new_ssm_prompt, new_pool_prompt,
            new_conv_sample, new_ssm_sample, new_pool_sample)
```

```cpp
#include <hip/hip_runtime.h>
#include <hip/hip_cooperative_groups.h>
#include <cstdio>
namespace cg = cooperative_groups;

#define LAS __attribute__((address_space(3)))
typedef unsigned short bf16_t;
typedef short bf16x8 __attribute__((ext_vector_type(8)));
typedef float f32x4 __attribute__((ext_vector_type(4)));
typedef unsigned u32x4 __attribute__((ext_vector_type(4)));
typedef unsigned u32x2 __attribute__((ext_vector_type(2)));

constexpr int DM = 2048;
constexpr int TP = 2176;
constexpr int PADR = 112;
constexpr int ROWS_P = 4 * TP;
constexpr int TROWS = ROWS_P + 1024;
constexpr int NPROJ = 13568;
constexpr int C_Z = 0, C_XBC = 2048, C_ZP = 5120, C_U = 7168, C_GS = 9216, C_GP = 11264, C_DT = 13312;
constexpr int CONVD = 3072;
constexpr float EPS = 1e-6f;
constexpr size_t O_YP = 0, O_YS = 16777216, O_CP = 18874368, O_SP = 18911232, O_PP = 19959808, O_CS = 20082688, O_SS = 21262336, O_PS = 54816768;
constexpr size_t W_XN = 0;
constexpr size_t W_WINT = 39845888;
constexpr size_t W_WSP = W_WINT + 55574528;
constexpr size_t W_WMIX = W_WSP + 16777216;
constexpr size_t W_WOUT = W_WMIX + 2097152;
constexpr size_t W_PROJ = W_WOUT + 8388608;
constexpr size_t W_DTRAW = W_PROJ + 263979008;
constexpr size_t W_A2 = W_DTRAW + 1245184;
constexpr size_t W_YSS = W_A2 + 79691776;
constexpr size_t W_RSS = W_YSS + 1245184;
constexpr size_t W_END = W_RSS + 1245184;
constexpr int LDS_BYTES = 147456;

struct Params {
    const float *x_prompt, *x_sample, *state_conv, *state_ssm, *state_pool, *meta, *norm_w, *w_in, *conv_w, *conv_b, *dt_bias, *a_log, *d_skip,
        *ssd_norm_w, *w_proj_ssd, *pool_mix_w, *pool_mix_b, *pool_scale, *w_proj_pool, *w_out, *final_norm_w;
    float* out;
    unsigned char* ws;
};

__device__ __forceinline__ float bf2f(unsigned b) { return __uint_as_float(b << 16); }
__device__ __forceinline__ float bflo(unsigned w) { return __uint_as_float(w << 16); }
__device__ __forceinline__ float bfhi(unsigned w) { return __uint_as_float(w & 0xffff0000u); }
__device__ __forceinline__ unsigned pk2(float lo, float hi) { unsigned r; asm("v_cvt_pk_bf16_f32 %0, %1, %2" : "=v"(r) : "v"(lo), "v"(hi)); return r; }
__device__ __forceinline__ bf16_t f2bf(float f) { return (bf16_t)(pk2(f, 0.f) & 0xffffu); }
__device__ __forceinline__ float sigmoidf_(float x) { return 1.0f / (1.0f + __expf(-x)); }
__device__ __forceinline__ float siluf_(float x) { return x / (1.0f + __expf(-x)); }
__device__ __forceinline__ float softplusf_(float x) { return x > 20.f ? x : log1pf(__expf(x)); }
__device__ __forceinline__ const float* row_src(const Params& p, int r) {
    if (r < ROWS_P) { const int b = r / TP, t = r - b * TP;
        if (t < PADR) return nullptr;
        if (t < 128) return p.meta + (size_t)(t - PADR) * DM;
        return p.x_prompt + ((size_t)b * 2048 + (t - 128)) * DM; }
    return p.x_sample + (size_t)(r - ROWS_P) * DM;
}
__device__ __forceinline__ float* row_dst(const Params& p, int r) {
    if (r < ROWS_P) { const int b = r / TP, t = r - b * TP;
        if (t < 128) return nullptr;
        return p.out + O_YP + ((size_t)b * 2048 + (t - 128)) * DM; }
    return p.out + O_YS + (size_t)(r - ROWS_P) * DM;
}

constexpr int BM = 256, BK = 64, HALF = 128, HTB = HALF * BK * 2, NXCD = 8, WGM = 8;
__device__ __forceinline__ int lds_byte(int r, int c) { const int st = (r >> 4) * 2 + (c >> 5), rr = r & 15, cc = c & 31, ob = rr * 64 + cc * 2; return st * 1024 + (ob ^ (((ob >> 9) & 1) << 5)); }
__device__ __forceinline__ void stage_rc(int b, int& R, int& C) { const int st = b / 1024, sb = b % 1024, swz = sb ^ (((sb >> 9) & 1) << 5); R = (st >> 1) * 16 + swz / 64; C = (st & 1) * 32 + (swz % 64) / 2; }
__device__ __forceinline__ int perm32(int rho) { const int n = rho >> 4, i = rho & 15; return 8 * (i >> 2) + 4 * n + (i & 3); }
struct Unit { int pm, pn, sub; };
struct GemmD { const bf16_t* A; const bf16_t* Bt; int lda, ldb, K, nM, nN, a_kdiv, a_kstride, nsub; };
__device__ __forceinline__ bool unit_next(const GemmD& g, int i, Unit& u) {
    u.sub = g.nsub == 2 ? (i & 1) : 0; if (g.nsub == 2) i >>= 1;
    const int nwg = g.nM * g.nN; const long L = (long)i * gridDim.x + blockIdx.x; if (L >= nwg) return false;
    int wgid = (int)L; { const int q = nwg / NXCD, r = nwg % NXCD, xcd = wgid % NXCD, off = wgid / NXCD; wgid = (xcd < r ? xcd * (q + 1) : r * (q + 1) + (xcd - r) * q) + off; }
    const int nig = WGM * g.nN, gid = wgid / nig, fm = gid * WGM, gsz = (g.nM - fm) < WGM ? (g.nM - fm) : WGM;
    u.pm = fm + ((wgid % nig) % gsz); u.pn = (wgid % nig) / gsz; return true;
}
__device__ __forceinline__ const char* unit_a(const GemmD& g, const Unit& u) { return (const char*)(g.A + (size_t)u.pm * BM * g.lda + (g.a_kdiv ? (u.pn / g.a_kdiv) * g.a_kstride : 0) + u.sub * g.K); }
__device__ __forceinline__ const char* unit_b(const GemmD& g, const Unit& u) { return (const char*)(g.Bt + (size_t)u.pn * BM * g.ldb + u.sub * g.K); }

template <class Epi>
__device__ __forceinline__ void gemm_phase(LAS unsigned char* lds, const GemmD g, const Epi& E) {
    const int tid = threadIdx.x, wid = __builtin_amdgcn_readfirstlane(tid >> 6), lane = tid & 63, wr = wid >> 2, wc = wid & 3, fr = lane & 15, fq = lane >> 4;
    const int K = g.K, nt = K / BK;
    unsigned voffA[2], voffB[2];
#pragma unroll
    for (int i = 0; i < 2; ++i) { int R, C; stage_rc(tid * 16 + i * 8192, R, C); const int Rb = (R & ~31) + perm32(R & 31);
        voffA[i] = (unsigned)(R * g.lda + C) * 2u; voffB[i] = (unsigned)(Rb * g.ldb + C) * 2u; }
    const size_t kstep = (size_t)(BK * 2);
    const size_t hstepA = (size_t)HALF * g.lda * 2, hstepB = (size_t)HALF * g.ldb * 2;
    const unsigned ldsw = (unsigned)wid * 1024u;
    const int aoff = lds_byte(wr * 64 + fr, fq * 8), boff = lds_byte(wc * 32 + fr, fq * 8);
#define PG8_SA(b, h) (((b) * 2 + (h)) * HTB)
#define PG8_SB(b, h) ((4 + (b) * 2 + (h)) * HTB)
#define PG8_STAGE(bufoff, gbase, voff) do { _Pragma("unroll") for (int _i = 0; _i < 2; ++_i) \
        __builtin_amdgcn_global_load_lds((const unsigned*)((const char*)(gbase) + (voff)[_i]), (LAS unsigned*)(lds + (bufoff) + ldsw + _i * 8192), 16, 0, 0); } while (0)
#define PG8_LDA(dst, b, h) do { _Pragma("unroll") for (int m = 0; m < 4; ++m) _Pragma("unroll") for (int k = 0; k < 2; ++k) dst[m][k] = *(const LAS bf16x8*)(lds + PG8_SA(b, h) + aoff + m * 2048 + k * 1024); } while (0)
#define PG8_LDB(dst, b, h) do { _Pragma("unroll") for (int n = 0; n < 2; ++n) _Pragma("unroll") for (int k = 0; k < 2; ++k) dst[n][k] = *(const LAS bf16x8*)(lds + PG8_SB(b, h) + boff + n * 2048 + k * 1024); } while (0)
#define PG8_MMA(ai, bj, At, Bt) do { __builtin_amdgcn_s_setprio(1); _Pragma("unroll") for (int m = 0; m < 4; ++m) _Pragma("unroll") for (int n = 0; n < 2; ++n) _Pragma("unroll") for (int k = 0; k < 2; ++k) \
        acc[ai][bj][m][n] = __builtin_amdgcn_mfma_f32_16x16x32_bf16(Bt[n][k], At[m][k], acc[ai][bj][m][n], 0, 0, 0); __builtin_amdgcn_s_setprio(0); } while (0)
#define PG8_WAIT_V(n) asm volatile("s_waitcnt vmcnt(" #n ")" ::: "memory")
#define PG8_WAIT_L(n) asm volatile("s_waitcnt lgkmcnt(" #n ")" ::: "memory")
#define PG8_BAR __builtin_amdgcn_s_barrier()
#define PG8_SCHED __builtin_amdgcn_sched_barrier(0)
    Unit cur, nxt; int ui = 0;
    if (!unit_next(g, 0, cur)) return;
    f32x4 acc[2][2][4][2];
#pragma unroll
    for (int a = 0; a < 2; ++a)
#pragma unroll
        for (int b = 0; b < 2; ++b)
#pragma unroll
            for (int m = 0; m < 4; ++m)
#pragma unroll
                for (int n = 0; n < 2; ++n) acc[a][b][m][n] = (f32x4){0.f, 0.f, 0.f, 0.f};
    bf16x8 At[4][2], B0[2][2], B1[2][2];
    const char* cA = unit_a(g, cur); const char* cB = unit_b(g, cur);
    PG8_STAGE(PG8_SB(0, 0), cB, voffB); PG8_STAGE(PG8_SA(0, 0), cA, voffA); PG8_STAGE(PG8_SB(0, 1), cB + hstepB, voffB); PG8_STAGE(PG8_SA(0, 1), cA + hstepA, voffA);
    if (wr == 1) PG8_BAR;
    PG8_WAIT_V(4); PG8_BAR;
    PG8_STAGE(PG8_SB(1, 0), cB + kstep, voffB); PG8_STAGE(PG8_SA(1, 0), cA + kstep, voffA); PG8_STAGE(PG8_SB(1, 1), cB + hstepB + kstep, voffB);
    PG8_WAIT_V(6); PG8_BAR;
    for (;;) {
        const bool has_next = unit_next(g, ui + 1, nxt);
        const char* nA = has_next ? unit_a(g, nxt) : cA; const char* nB = has_next ? unit_b(g, nxt) : cB;
#define PG8_KITER(t) do { \
            const bool last = ((t) == nt - 2); \
            const char* a1 = cA + (size_t)((t) + 1) * kstep; \
            const char* a2 = last ? nA : cA + (size_t)((t) + 2) * kstep; const char* b2 = last ? nB : cB + (size_t)((t) + 2) * kstep; \
            const char* a3 = a2 + kstep; const char* b3 = b2 + kstep; \
            PG8_LDB(B0, 0, 0); PG8_SCHED; PG8_LDA(At, 0, 0); PG8_STAGE(PG8_SA(1, 1), a1 + hstepA, voffA); \
            PG8_WAIT_L(8); PG8_BAR; PG8_WAIT_L(0); PG8_MMA(0, 0, At, B0); PG8_BAR; PG8_SCHED; \
            PG8_LDB(B1, 0, 1); PG8_STAGE(PG8_SB(0, 0), b2, voffB); \
            PG8_BAR; PG8_WAIT_L(0); PG8_MMA(0, 1, At, B1); PG8_BAR; \
            PG8_LDA(At, 0, 1); PG8_STAGE(PG8_SA(0, 0), a2, voffA); \
            PG8_BAR; PG8_WAIT_L(0); PG8_MMA(1, 0, At, B0); PG8_BAR; PG8_SCHED; \
            PG8_STAGE(PG8_SB(0, 1), b2 + hstepB, voffB); \
            PG8_WAIT_V(6); PG8_BAR; PG8_MMA(1, 1, At, B1); PG8_BAR; \
            PG8_LDB(B0, 1, 0); PG8_SCHED; PG8_LDA(At, 1, 0); PG8_STAGE(PG8_SA(0, 1), a2 + hstepA, voffA); \
            PG8_WAIT_L(8); PG8_BAR; PG8_WAIT_L(0); PG8_MMA(0, 0, At, B0); PG8_BAR; PG8_SCHED; \
            PG8_LDB(B1, 1, 1); PG8_STAGE(PG8_SB(1, 0), b3, voffB); \
            PG8_BAR; PG8_WAIT_L(0); PG8_MMA(0, 1, At, B1); PG8_BAR; \
            PG8_LDA(At, 1, 1); PG8_STAGE(PG8_SA(1, 0), a3, voffA); \
            PG8_BAR; PG8_WAIT_L(0); PG8_MMA(1, 0, At, B0); PG8_BAR; PG8_SCHED; \
            PG8_STAGE(PG8_SB(1, 1), b3 + hstepB, voffB); \
            PG8_WAIT_V(6); PG8_BAR; PG8_MMA(1, 1, At, B1); PG8_BAR; } while (0)
        for (int t = 0; t < nt; t += 2) PG8_KITER(t);
#undef PG8_KITER
        bool keep = false;
        if constexpr (Epi::MID) { if (cur.sub == 0) { E.mid(acc, cur, wr, wc, fr, fq); keep = true; } else E(acc, cur, wr, wc, fr, fq); }
        else E(acc, cur, wr, wc, fr, fq);
        if (!has_next) break;
        cur = nxt; cA = nA; cB = nB; ++ui;
        if (keep) continue;
#pragma unroll
        for (int a = 0; a < 2; ++a)
#pragma unroll
            for (int b = 0; b < 2; ++b)
#pragma unroll
                for (int m = 0; m < 4; ++m)
#pragma unroll
                    for (int n = 0; n < 2; ++n) acc[a][b][m][n] = (f32x4){0.f, 0.f, 0.f, 0.f};
    }
    PG8_WAIT_V(0);
    if (wr == 0) PG8_BAR;
    PG8_BAR;
#undef PG8_SA
#undef PG8_SB
#undef PG8_STAGE
#undef PG8_LDA
#undef PG8_LDB
#undef PG8_MMA
#undef PG8_WAIT_V
#undef PG8_WAIT_L
#undef PG8_BAR
#undef PG8_SCHED
}

struct EpiProj {
    static constexpr bool MID = false;
    bf16_t* proj; float* dtraw;
    __device__ __forceinline__ void mid(f32x4 (&)[2][2][4][2], const Unit&, int, int, int, int) const {}
    __device__ __forceinline__ void operator()(const f32x4 (&acc)[2][2][4][2], const Unit& u, int wr, int wc, int fr, int fq) const {
        const int row0 = u.pm * BM + wr * 64 + fr, col0 = u.pn * BM + wc * 32 + 8 * fq;
        const bool sig = (u.pn >= 36 && u.pn < 52), isdt = (u.pn == 52);
#pragma unroll
        for (int ai = 0; ai < 2; ++ai)
#pragma unroll
            for (int m = 0; m < 4; ++m) { const int row = row0 + ai * HALF + m * 16;
#pragma unroll
                for (int bj = 0; bj < 2; ++bj) { const f32x4 v0 = acc[ai][bj][m][0], v1 = acc[ai][bj][m][1]; const int col = col0 + bj * HALF;
                    if (sig) {
                        const int c = (col - C_GS) >> 1;
                        float ra[4], gp[4];
#pragma unroll
                        for (int j = 0; j < 4; ++j) { const float ea = __expf(-v0[j]), eb = __expf(-v1[j]); gp[j] = 1.0f / (1.0f + eb); ra[j] = fminf((1.0f + eb) / (1.0f + ea), 3.0e38f); }
                        u32x2 wr_, wg; wr_.x = pk2(ra[0], ra[1]); wr_.y = pk2(ra[2], ra[3]); wg.x = pk2(gp[0], gp[1]); wg.y = pk2(gp[2], gp[3]);
                        *(u32x2*)(proj + (size_t)row * NPROJ + C_GS + c) = wr_;
                        *(u32x2*)(proj + (size_t)row * NPROJ + C_GP + c) = wg;
                    } else {
                        u32x4 w; w.x = pk2(v0[0], v0[1]); w.y = pk2(v0[2], v0[3]); w.z = pk2(v1[0], v1[1]); w.w = pk2(v1[2], v1[3]);
                        *(u32x4*)(proj + (size_t)row * NPROJ + col) = w;
                        if (isdt && col < C_DT + 32) { float* d = dtraw + (size_t)row * 32 + (col - C_DT); *(f32x4*)d = v0; *(f32x4*)(d + 4) = v1; } } } }
    }
};
struct EpiMix {
    static constexpr bool MID = false;
    const bf16_t* proj; bf16_t* a2; const float* bias; const float* scale;
    __device__ __forceinline__ void mid(f32x4 (&)[2][2][4][2], const Unit&, int, int, int, int) const {}
    __device__ __forceinline__ void operator()(const f32x4 (&acc)[2][2][4][2], const Unit& u, int wr, int wc, int fr, int fq) const {
        const int row0 = u.pm * BM + wr * 64 + fr, col0 = u.pn * BM + wc * 32 + 8 * fq;
#pragma unroll
        for (int bj = 0; bj < 2; ++bj) { const int col = col0 + bj * HALF;
            const f32x4 b0 = *(const f32x4*)(bias + col), b1 = *(const f32x4*)(bias + col + 4), s0 = *(const f32x4*)(scale + col), s1 = *(const f32x4*)(scale + col + 4);
#pragma unroll
            for (int ai = 0; ai < 2; ++ai)
#pragma unroll
                for (int m = 0; m < 4; ++m) { const int row = row0 + ai * HALF + m * 16;
                    const u32x4 z = *(const u32x4*)(proj + (size_t)row * NPROJ + C_ZP + col);
                    f32x4 v0 = (acc[ai][bj][m][0] + b0) * s0, v1 = (acc[ai][bj][m][1] + b1) * s1;
                    v0[0] *= siluf_(bflo(z.x)); v0[1] *= siluf_(bfhi(z.x)); v0[2] *= siluf_(bflo(z.y)); v0[3] *= siluf_(bfhi(z.y));
                    v1[0] *= siluf_(bflo(z.z)); v1[1] *= siluf_(bfhi(z.z)); v1[2] *= siluf_(bflo(z.w)); v1[3] *= siluf_(bfhi(z.w));
                    u32x4 w; w.x = pk2(v0[0], v0[1]); w.y = pk2(v0[2], v0[3]); w.z = pk2(v1[0], v1[1]); w.w = pk2(v1[2], v1[3]);
                    *(u32x4*)(a2 + (size_t)row * 4096 + 2048 + col) = w; } }
    }
};
struct EpiMerged {
    static constexpr bool MID = true;
    const bf16_t* proj; bf16_t* merged;
    __device__ __forceinline__ void mid(f32x4 (&acc)[2][2][4][2], const Unit& u, int wr, int wc, int fr, int fq) const {
        const int row0 = u.pm * BM + wr * 64 + fr, col0 = u.pn * BM + wc * 32 + 8 * fq;
        u32x4 rv[2][2];
        { const bf16_t* rp = proj + (size_t)row0 * NPROJ + C_GS + col0; rv[0][0] = *(const u32x4*)(rp); rv[0][1] = *(const u32x4*)(rp + HALF); }
#pragma unroll
        for (int st = 0; st < 8; ++st) { const int ai = st >> 2, m = st & 3, cb = st & 1, nb = cb ^ 1;
            if (st + 1 < 8) { const int ai2 = (st + 1) >> 2, m2 = (st + 1) & 3; const bf16_t* rp = proj + (size_t)(row0 + ai2 * HALF + m2 * 16) * NPROJ + C_GS + col0;
                rv[nb][0] = *(const u32x4*)(rp); rv[nb][1] = *(const u32x4*)(rp + HALF); }
#pragma unroll
            for (int bj = 0; bj < 2; ++bj) { const u32x4 r = rv[cb][bj];
                acc[ai][bj][m][0] *= (f32x4){bflo(r.x), bfhi(r.x), bflo(r.y), bfhi(r.y)}; acc[ai][bj][m][1] *= (f32x4){bflo(r.z), bfhi(r.z), bflo(r.w), bfhi(r.w)}; }
            __builtin_amdgcn_sched_barrier(0);
        }
    }
    __device__ __forceinline__ void operator()(const f32x4 (&acc)[2][2][4][2], const Unit& u, int wr, int wc, int fr, int fq) const {
        const int row0 = u.pm * BM + wr * 64 + fr, col0 = u.pn * BM + wc * 32 + 8 * fq;
#pragma unroll
        for (int ai = 0; ai < 2; ++ai)
#pragma unroll
            for (int m = 0; m < 4; ++m) { const int row = row0 + ai * HALF + m * 16;
#pragma unroll
                for (int bj = 0; bj < 2; ++bj) { const int col = col0 + bj * HALF;
                    const u32x4 gp = *(const u32x4*)(proj + (size_t)row * NPROJ + C_GP + col);
                    const f32x4 v0 = acc[ai][bj][m][0], v1 = acc[ai][bj][m][1];
                    u32x4 w; w.x = pk2(v0[0] * bflo(gp.x), v0[1] * bfhi(gp.x)); w.y = pk2(v0[2] * bflo(gp.y), v0[3] * bfhi(gp.y));
                    w.z = pk2(v1[0] * bflo(gp.z), v1[1] * bfhi(gp.z)); w.w = pk2(v1[2] * bflo(gp.w), v1[3] * bfhi(gp.w));
                    *(u32x4*)(merged + (size_t)row * DM + col) = w; } }
    }
};
struct EpiOut {
    static constexpr bool MID = false;
    Params p; float* rss;
    __device__ __forceinline__ void mid(f32x4 (&)[2][2][4][2], const Unit&, int, int, int, int) const {}
    __device__ __forceinline__ void operator()(const f32x4 (&acc)[2][2][4][2], const Unit& u, int wr, int wc, int fr, int fq) const {
        const int row0 = u.pm * BM + wr * 64 + fr, col0 = u.pn * BM + wc * 32 + 8 * fq;
#pragma unroll
        for (int ai = 0; ai < 2; ++ai)
#pragma unroll
            for (int m = 0; m < 4; ++m) { const int row = row0 + ai * HALF + m * 16;
                const float* src = row_src(p, row); float* dst = row_dst(p, row); float ss = 0.f;
                if (dst) {
#pragma unroll
                    for (int bj = 0; bj < 2; ++bj) { const int col = col0 + bj * HALF;
                        const f32x4 h0 = *(const f32x4*)(src + col), h1 = *(const f32x4*)(src + col + 4);
                        const f32x4 v0 = acc[ai][bj][m][0] + h0, v1 = acc[ai][bj][m][1] + h1;
                        *(f32x4*)(dst + col) = v0; *(f32x4*)(dst + col + 4) = v1;
                        ss += v0[0] * v0[0] + v0[1] * v0[1] + v0[2] * v0[2] + v0[3] * v0[3] + v1[0] * v1[0] + v1[1] * v1[1] + v1[2] * v1[2] + v1[3] * v1[3]; } }
                ss += __shfl_xor(ss, 16); ss += __shfl_xor(ss, 32);
                if (fq == 0) rss[(size_t)row * 32 + u.pn * 4 + wc] = ss; }
    }
};

__device__ __forceinline__ int win_src_col(int n) {
    if (n < 5120) return n;
    if (n < C_GS) return n + 32;
    if (n < C_DT) { const int j = n - C_GS, k = j >> 3, wi = j & 7; return ((wi >> 2) ? 11296 : 9248) + 4 * k + (wi & 3); }
    if (n < C_DT + 32) return n - C_DT + 5120;
    return -1;
}
__device__ __forceinline__ void transpose_tile(const float* src, int sld, bf16_t* dst, int dld, int k0, int n0, bool remap, float* tile) {
    const int tid = threadIdx.x;
    { const int n = tid & 63, kb = tid >> 6; const int sc = remap ? win_src_col(n0 + n) : (n0 + n);
#pragma unroll
        for (int ps = 0; ps < 8; ++ps) { const int k = ps * 8 + kb; tile[k * 65 + n] = sc >= 0 ? src[(size_t)(k0 + k) * sld + sc] : 0.f; } }
    __syncthreads();
    { const int n = tid >> 3, kg = tid & 7; float v[8];
#pragma unroll
        for (int j = 0; j < 8; ++j) v[j] = tile[(kg * 8 + j) * 65 + n];
        u32x4 w; w.x = pk2(v[0], v[1]); w.y = pk2(v[2], v[3]); w.z = pk2(v[4], v[5]); w.w = pk2(v[6], v[7]);
        *(u32x4*)(dst + (size_t)(n0 + n) * dld + k0 + kg * 8) = w; }
    __syncthreads();
}
__device__ __forceinline__ void phase_prep(const Params& p, float* tile) {
    const int tid = threadIdx.x, wid = tid >> 6, lane = tid & 63;
    bf16_t* XN = (bf16_t*)(p.ws + W_XN);
    for (int r = blockIdx.x * 8 + wid; r < TROWS; r += gridDim.x * 8) {
        const float* src = row_src(p, r); bf16_t* dst = XN + (size_t)r * DM;
        if (!src) {
#pragma unroll
            for (int i = 0; i < 4; ++i) *(u32x4*)(dst + (lane + 64 * i) * 8) = (u32x4){0u, 0u, 0u, 0u};
        } else {
            f32x4 v[8]; float ss = 0.f;
#pragma unroll
            for (int i = 0; i < 8; ++i) { v[i] = ((const f32x4*)src)[lane + 64 * i]; ss += v[i][0] * v[i][0] + v[i][1] * v[i][1] + v[i][2] * v[i][2] + v[i][3] * v[i][3]; }
#pragma unroll
            for (int o = 32; o >= 1; o >>= 1) ss += __shfl_xor(ss, o);
            const float rs = rsqrtf(ss * (1.0f / DM) + EPS);
#pragma unroll
            for (int i = 0; i < 8; ++i) { const f32x4 w = ((const f32x4*)p.norm_w)[lane + 64 * i];
                u32x2 o; o.x = pk2(v[i][0] * rs * w[0], v[i][1] * rs * w[1]); o.y = pk2(v[i][2] * rs * w[2], v[i][3] * rs * w[3]);
                *(u32x2*)(dst + (lane + 64 * i) * 4) = o; }
        }
    }
    bf16_t* WINT = (bf16_t*)(p.ws + W_WINT); bf16_t* WSP = (bf16_t*)(p.ws + W_WSP); bf16_t* WMIX = (bf16_t*)(p.ws + W_WMIX); bf16_t* WOUT = (bf16_t*)(p.ws + W_WOUT);
    constexpr int NT_IN = 212 * 32, NT_SQ = 32 * 32, NT_MIX = 4 * 64;
    for (int it = blockIdx.x; it < NT_IN + 3 * NT_SQ + NT_MIX; it += gridDim.x) {
        if (it < NT_IN) { const int nt_ = it >> 5, kt = it & 31; transpose_tile(p.w_in, 13344, WINT, DM, kt * 64, nt_ * 64, true, tile); }
        else if (it < NT_IN + NT_SQ) { const int j = it - NT_IN; transpose_tile(p.w_proj_ssd, DM, WSP, 4096, (j & 31) * 64, (j >> 5) * 64, false, tile); }
        else if (it < NT_IN + 2 * NT_SQ) { const int j = it - NT_IN - NT_SQ; transpose_tile(p.w_proj_pool, DM, WSP + 2048, 4096, (j & 31) * 64, (j >> 5) * 64, false, tile); }
        else if (it < NT_IN + 3 * NT_SQ) { const int j = it - NT_IN - 2 * NT_SQ; transpose_tile(p.w_out, DM, WOUT, DM, (j & 31) * 64, (j >> 5) * 64, false, tile); }
        else { const int j = it - NT_IN - 3 * NT_SQ; const int gq = j >> 6, r = j & 63;
            transpose_tile(p.pool_mix_w + (size_t)gq * 512 * 512, 512, WMIX + (size_t)gq * 512 * 512, 512, (r & 7) * 64, (r >> 3) * 64, false, tile); }
    }
}

constexpr int LROW = 136;
__device__ __forceinline__ void ssd_prompt(const Params& p, unsigned char* smem, int b, int h) {
    const int tid = threadIdx.x, wid = __builtin_amdgcn_readfirstlane(tid >> 6), lane = tid & 63, fr = lane & 15, fq = lane >> 4;
    const int g = h >> 3;
    bf16_t* sB = (bf16_t*)(smem);
    bf16_t* sBT = (bf16_t*)(smem + 34816);
    bf16_t* sC = (bf16_t*)(smem + 69632);
    bf16_t* sXT = (bf16_t*)(smem + 104448);
    bf16_t* sH = (bf16_t*)(smem + 121856);
    float* sDt = (float*)(smem + 139264);
    float* sAc = sDt + 128;
    const bf16_t* PROJ = (const bf16_t*)(p.ws + W_PROJ);
    const float* DTRAW = (const float*)(p.ws + W_DTRAW);
    bf16_t* A2 = (bf16_t*)(p.ws + W_A2);
    float* YSS = (float*)(p.ws + W_YSS);
    const float a = -__expf(p.a_log[h]), dtb = p.dt_bias[h], Dh = p.d_skip[h];
    for (int i = tid; i < 64 * LROW / 2; i += 512) ((unsigned*)sH)[i] = 0u;
    f32x4 hacc[4];
#pragma unroll
    for (int i = 0; i < 4; ++i) hacc[i] = (f32x4){0.f, 0.f, 0.f, 0.f};
    for (int c = 0; c < 17; ++c) {
        const int base = b * TP + c * 128;
        if (wid == 0) {
            const int t0 = 2 * lane;
            float d0 = softplusf_(DTRAW[(size_t)(base + t0) * 32 + h] + dtb), d1 = softplusf_(DTRAW[(size_t)(base + t0 + 1) * 32 + h] + dtb);
            if (c == 0) { if (t0 < PADR) d0 = 0.f; if (t0 + 1 < PADR) d1 = 0.f; }
            const float v0 = d0 * a, v1 = d1 * a, s = v0 + v1; float incl = s;
#pragma unroll
            for (int o = 1; o < 64; o <<= 1) { const float nb = __shfl_up(incl, o); if (lane >= o) incl += nb; }
            const float excl = incl - s;
            sDt[t0] = d0; sDt[t0 + 1] = d1; sAc[t0] = excl + v0; sAc[t0 + 1] = excl + s;
        }
        for (int item = tid; item < 1280; item += 512) {
            const int cgi = item % 40, run = item / 40;
            int cc; if (cgi < 8) cc = h * 64 + cgi * 8; else if (cgi < 24) cc = 2048 + g * 128 + (cgi - 8) * 8; else cc = 2560 + g * 128 + (cgi - 24) * 8;
            const int r0 = base + run * 4;
            u32x4 L[7];
#pragma unroll
            for (int k = 0; k < 7; ++k) { int rr = r0 - 3 + k; rr = rr < 0 ? 0 : rr; L[k] = *(const u32x4*)(PROJ + (size_t)rr * NPROJ + C_XBC + cc); }
            float o[4][8];
#pragma unroll
            for (int hj = 0; hj < 2; ++hj) {
                const f32x4 w0 = *(const f32x4*)(p.conv_w + 0 * CONVD + cc + 4 * hj), w1 = *(const f32x4*)(p.conv_w + 1 * CONVD + cc + 4 * hj),
                            w2 = *(const f32x4*)(p.conv_w + 2 * CONVD + cc + 4 * hj), w3 = *(const f32x4*)(p.conv_w + 3 * CONVD + cc + 4 * hj), bb = *(const f32x4*)(p.conv_b + cc + 4 * hj);
#pragma unroll
                for (int i = 0; i < 4; ++i) {
                    const unsigned a0 = hj ? L[i].z : L[i].x, a1 = hj ? L[i].w : L[i].y, b0 = hj ? L[i + 1].z : L[i + 1].x, b1 = hj ? L[i + 1].w : L[i + 1].y,
                                   c0 = hj ? L[i + 2].z : L[i + 2].x, c1 = hj ? L[i + 2].w : L[i + 2].y, d0 = hj ? L[i + 3].z : L[i + 3].x, d1 = hj ? L[i + 3].w : L[i + 3].y;
                    o[i][4 * hj + 0] = siluf_(bb[0] + bflo(a0) * w0[0] + bflo(b0) * w1[0] + bflo(c0) * w2[0] + bflo(d0) * w3[0]);
                    o[i][4 * hj + 1] = siluf_(bb[1] + bfhi(a0) * w0[1] + bfhi(b0) * w1[1] + bfhi(c0) * w2[1] + bfhi(d0) * w3[1]);
                    o[i][4 * hj + 2] = siluf_(bb[2] + bflo(a1) * w0[2] + bflo(b1) * w1[2] + bflo(c1) * w2[2] + bflo(d1) * w3[2]);
                    o[i][4 * hj + 3] = siluf_(bb[3] + bfhi(a1) * w0[3] + bfhi(b1) * w1[3] + bfhi(c1) * w2[3] + bfhi(d1) * w3[3]);
                }
            }
            const int s0 = run * 4;
            if (cgi < 8) {
#pragma unroll
                for (int j = 0; j < 8; ++j) { u32x2 w; w.x = pk2(o[0][j], o[1][j]); w.y = pk2(o[2][j], o[3][j]); *(u32x2*)(sXT + (cgi * 8 + j) * LROW + s0) = w; }
            } else if (cgi < 24) {
                const int n0 = (cgi - 8) * 8;
#pragma unroll
                for (int i = 0; i < 4; ++i) { u32x4 w; w.x = pk2(o[i][0], o[i][1]); w.y = pk2(o[i][2], o[i][3]); w.z = pk2(o[i][4], o[i][5]); w.w = pk2(o[i][6], o[i][7]); *(u32x4*)(sB + (s0 + i) * LROW + n0) = w; }
#pragma unroll
                for (int j = 0; j < 8; ++j) { u32x2 w; w.x = pk2(o[0][j], o[1][j]); w.y = pk2(o[2][j], o[3][j]); *(u32x2*)(sBT + (n0 + j) * LROW + s0) = w; }
            } else {
                const int n0 = (cgi - 24) * 8;
#pragma unroll
                for (int i = 0; i < 4; ++i) { u32x4 w; w.x = pk2(o[i][0], o[i][1]); w.y = pk2(o[i][2], o[i][3]); w.z = pk2(o[i][4], o[i][5]); w.w = pk2(o[i][6], o[i][7]); *(u32x4*)(sC + (s0 + i) * LROW + n0) = w; }
            }
        }
        __syncthreads();
        const int trow = 16 * wid + fr;
        const float act = sAc[trow];
        bf16x8 cf[4];
#pragma unroll
        for (int kk = 0; kk < 4; ++kk) cf[kk] = *(const bf16x8*)(sC + trow * LROW + 32 * kk + 8 * fq);
        bf16x8 gfrag[4];
#pragma unroll
        for (int kb = 0; kb < 4; ++kb) {
            unsigned pkd[4] = {0u, 0u, 0u, 0u};
#pragma unroll
            for (int hf = 0; hf < 2; ++hf) { const int st = 2 * kb + hf;
                if (st <= wid) {
                    f32x4 d = (f32x4){0.f, 0.f, 0.f, 0.f};
#pragma unroll
                    for (int kk = 0; kk < 4; ++kk) { const bf16x8 bfr = *(const bf16x8*)(sB + (16 * st + fr) * LROW + 32 * kk + 8 * fq); d = __builtin_amdgcn_mfma_f32_16x16x32_bf16(bfr, cf[kk], d, 0, 0, 0); }
                    const f32x4 acs = *(const f32x4*)(sAc + 16 * st + 4 * fq), dts = *(const f32x4*)(sDt + 16 * st + 4 * fq);
                    float gv[4];
#pragma unroll
                    for (int jj = 0; jj < 4; ++jj) { const int s = 16 * st + 4 * fq + jj; gv[jj] = (s <= trow) ? d[jj] * __expf(act - acs[jj]) * dts[jj] : 0.f; }
                    pkd[2 * hf] = pk2(gv[0], gv[1]); pkd[2 * hf + 1] = pk2(gv[2], gv[3]);
                } }
            u32x4 w; w.x = pkd[0]; w.y = pkd[1]; w.z = pkd[2]; w.w = pkd[3];
            gfrag[kb] = __builtin_bit_cast(bf16x8, w);
        }
        const float eact = __expf(act);
        const int grow = base + trow;
        float ssq = 0.f;
#pragma unroll
        for (int pt = 0; pt < 4; ++pt) {
            f32x4 y = (f32x4){0.f, 0.f, 0.f, 0.f};
#pragma unroll
            for (int kk = 0; kk < 4; ++kk) { const bf16x8 hf = *(const bf16x8*)(sH + (16 * pt + fr) * LROW + 32 * kk + 8 * fq); y = __builtin_amdgcn_mfma_f32_16x16x32_bf16(hf, cf[kk], y, 0, 0, 0); }
            y *= eact;
#pragma unroll
            for (int kb = 0; kb < 4; ++kb) {
                if (2 * kb <= wid) {
                    const u32x2 x0 = *(const u32x2*)(sXT + (16 * pt + fr) * LROW + 32 * kb + 4 * fq), x1 = *(const u32x2*)(sXT + (16 * pt + fr) * LROW + 32 * kb + 16 + 4 * fq);
                    u32x4 w; w.x = x0.x; w.y = x0.y; w.z = x1.x; w.w = x1.y;
                    y = __builtin_amdgcn_mfma_f32_16x16x32_bf16(__builtin_bit_cast(bf16x8, w), gfrag[kb], y, 0, 0, 0);
                } }
            const int pc = 16 * pt + 4 * fq;
            const u32x2 zz = *(const u32x2*)(PROJ + (size_t)grow * NPROJ + C_Z + h * 64 + pc);
            const float zf[4] = {bflo(zz.x), bfhi(zz.x), bflo(zz.y), bfhi(zz.y)};
            float yo[4];
#pragma unroll
            for (int jj = 0; jj < 4; ++jj) { const float xv = bf2f(sXT[(pc + jj) * LROW + trow]); const float v = (y[jj] + Dh * xv) * siluf_(zf[jj]); yo[jj] = v; ssq += v * v; }
            u32x2 w; w.x = pk2(yo[0], yo[1]); w.y = pk2(yo[2], yo[3]);
            *(u32x2*)(A2 + (size_t)grow * 4096 + h * 64 + pc) = w;
        }
        ssq += __shfl_xor(ssq, 16); ssq += __shfl_xor(ssq, 32);
        if (fq == 0) YSS[(size_t)grow * 32 + h] = ssq;
        __syncthreads();
        {
            const float aT = sAc[127], dec = __expf(aT);
            const int ptile = wid & 3, nt0 = (wid >> 2) * 4;
#pragma unroll
            for (int i = 0; i < 4; ++i) hacc[i] *= dec;
#pragma unroll
            for (int kk = 0; kk < 4; ++kk) {
                const int sb = 32 * kk + 8 * fq;
                const u32x4 xr = *(const u32x4*)(sXT + (16 * ptile + fr) * LROW + sb);
                const f32x4 a0 = *(const f32x4*)(sAc + sb), a1 = *(const f32x4*)(sAc + sb + 4), d0 = *(const f32x4*)(sDt + sb), d1 = *(const f32x4*)(sDt + sb + 4);
                u32x4 w;
                w.x = pk2(bflo(xr.x) * __expf(aT - a0[0]) * d0[0], bfhi(xr.x) * __expf(aT - a0[1]) * d0[1]);
                w.y = pk2(bflo(xr.y) * __expf(aT - a0[2]) * d0[2], bfhi(xr.y) * __expf(aT - a0[3]) * d0[3]);
                w.z = pk2(bflo(xr.z) * __expf(aT - a1[0]) * d1[0], bfhi(xr.z) * __expf(aT - a1[1]) * d1[1]);
                w.w = pk2(bflo(xr.w) * __expf(aT - a1[2]) * d1[2], bfhi(xr.w) * __expf(aT - a1[3]) * d1[3]);
                const bf16x8 xa = __builtin_bit_cast(bf16x8, w);
#pragma unroll
                for (int i = 0; i < 4; ++i) { const bf16x8 bfr = *(const bf16x8*)(sBT + (16 * (nt0 + i) + fr) * LROW + sb); hacc[i] = __builtin_amdgcn_mfma_f32_16x16x32_bf16(xa, bfr, hacc[i], 0, 0, 0); }
            }
#pragma unroll
            for (int i = 0; i < 4; ++i)
#pragma unroll
                for (int jj = 0; jj < 4; ++jj) sH[(16 * ptile + 4 * fq + jj) * LROW + 16 * (nt0 + i) + fr] = f2bf(hacc[i][jj]);
        }
        __syncthreads();
    }
    { const int ptile = wid & 3, nt0 = (wid >> 2) * 4; float* dst = p.out + O_SP + ((size_t)(b * 32 + h) * 64) * 128;
#pragma unroll
        for (int i = 0; i < 4; ++i)
#pragma unroll
            for (int jj = 0; jj < 4; ++jj) dst[(16 * ptile + 4 * fq + jj) * 128 + 16 * (nt0 + i) + fr] = hacc[i][jj]; }
}

__device__ __forceinline__ void ssd_sample(const Params& p, unsigned char* smem, int s, int g) {
    const int tid = threadIdx.x, wid = tid >> 6, lane = tid & 63;
    float* sx = (float*)smem;
    float* sBs = sx + 4096;
    float* sCs = sBs + 1024;
    float* sCB = sCs + 1024;
    float* sDt2 = sCB + 64;
    float* sAc2 = sDt2 + 64;
    float* sSS = sAc2 + 64;
    const bf16_t* PROJ = (const bf16_t*)(p.ws + W_PROJ);
    const float* DTRAW = (const float*)(p.ws + W_DTRAW);
    bf16_t* A2 = (bf16_t*)(p.ws + W_A2);
    float* YSS = (float*)(p.ws + W_YSS);
    const int rbase = ROWS_P + s * 8;
    for (int col = tid; col < 768; col += 512) {
        int cc; if (col < 512) cc = g * 512 + col; else if (col < 640) cc = 2048 + g * 128 + (col - 512); else cc = 2560 + g * 128 + (col - 640);
        float v[11];
#pragma unroll
        for (int k = 0; k < 3; ++k) v[k] = p.state_conv[((size_t)s * 3 + k) * CONVD + cc];
#pragma unroll
        for (int i = 0; i < 8; ++i) v[3 + i] = bf2f(PROJ[(size_t)(rbase + i) * NPROJ + C_XBC + cc]);
        const float w0 = p.conv_w[cc], w1 = p.conv_w[CONVD + cc], w2 = p.conv_w[2 * CONVD + cc], w3 = p.conv_w[3 * CONVD + cc], bb = p.conv_b[cc];
        float* dstp = col < 512 ? (sx + col) : (col < 640 ? sBs + (col - 512) : sCs + (col - 640));
        const int dstride = col < 512 ? 512 : 128;
#pragma unroll
        for (int i = 0; i < 8; ++i) dstp[i * dstride] = siluf_(bb + v[i] * w0 + v[i + 1] * w1 + v[i + 2] * w2 + v[i + 3] * w3);
#pragma unroll
        for (int j = 0; j < 3; ++j) p.out[O_CS + ((size_t)s * 3 + j) * CONVD + cc] = v[8 + j];
    }
    if (tid < 64) { const int hh = tid >> 3, t = tid & 7, h = g * 8 + hh;
        const float dt = softplusf_(DTRAW[(size_t)(rbase + t) * 32 + h] + p.dt_bias[h]);
        float v = dt * (-__expf(p.a_log[h]));
#pragma unroll
        for (int o = 1; o < 8; o <<= 1) { const float nb = __shfl_up(v, o, 8); if (t >= o) v += nb; }
        sDt2[tid] = dt; sAc2[tid] = v; }
    __syncthreads();
    if (tid < 64) { const int t = tid >> 3, s2 = tid & 7; float d = 0.f;
        for (int n = 0; n < 128; ++n) d += sCs[t * 128 + n] * sBs[s2 * 128 + n];
        sCB[tid] = d; }
    __syncthreads();
    const int pp = tid >> 3, nq = tid & 7;
    for (int hh = 0; hh < 8; ++hh) {
        const int h = g * 8 + hh;
        const size_t sidx = (((size_t)s * 32 + h) * 64 + pp) * 128 + 4 * nq;
        f32x4 hv[4];
#pragma unroll
        for (int j = 0; j < 4; ++j) hv[j] = *(const f32x4*)(p.state_ssm + sidx + 32 * j);
        float yoff[8];
#pragma unroll
        for (int t = 0; t < 8; ++t) { float acc = 0.f;
#pragma unroll
            for (int j = 0; j < 4; ++j) { const f32x4 c4 = *(const f32x4*)(sCs + t * 128 + 4 * nq + 32 * j); acc += c4[0] * hv[j][0] + c4[1] * hv[j][1] + c4[2] * hv[j][2] + c4[3] * hv[j][3]; }
            acc += __shfl_xor(acc, 1); acc += __shfl_xor(acc, 2); acc += __shfl_xor(acc, 4); yoff[t] = acc; }
        float my = yoff[0];
#pragma unroll
        for (int t = 1; t < 8; ++t) my = (nq == t) ? yoff[t] : my;
        float xs[8], ac[8], dt8[8];
#pragma unroll
        for (int t = 0; t < 8; ++t) { xs[t] = sx[t * 512 + hh * 64 + pp]; ac[t] = sAc2[hh * 8 + t]; dt8[t] = sDt2[hh * 8 + t]; }
        {
            const int t = nq; float act = ac[0], xt = xs[0];
#pragma unroll
            for (int k = 1; k < 8; ++k) { act = (t == k) ? ac[k] : act; xt = (t == k) ? xs[k] : xt; }
            float y = __expf(act) * my;
#pragma unroll
            for (int s2 = 0; s2 < 8; ++s2) { const float term = sCB[t * 8 + s2] * __expf(fminf(act - ac[s2], 0.f)) * dt8[s2] * xs[s2]; y += (s2 <= t) ? term : 0.f; }
            y += p.d_skip[h] * xt;
            const float z = bf2f(PROJ[(size_t)(rbase + t) * NPROJ + C_Z + h * 64 + pp]);
            y *= siluf_(z);
            A2[(size_t)(rbase + t) * 4096 + h * 64 + pp] = f2bf(y);
            float sq = y * y; sq += __shfl_xor(sq, 8); sq += __shfl_xor(sq, 16); sq += __shfl_xor(sq, 32);
            if (lane < 8) sSS[(hh * 8 + nq) * 8 + wid] = sq;
        }
        const float aT = ac[7], dec = __expf(aT);
        float xw[8];
#pragma unroll
        for (int s2 = 0; s2 < 8; ++s2) xw[s2] = __expf(aT - ac[s2]) * dt8[s2] * xs[s2];
#pragma unroll
        for (int j = 0; j < 4; ++j) { f32x4 hn = hv[j] * dec;
#pragma unroll
            for (int s2 = 0; s2 < 8; ++s2) { const f32x4 b4 = *(const f32x4*)(sBs + s2 * 128 + 4 * nq + 32 * j); hn += b4 * xw[s2]; }
            *(f32x4*)(p.out + O_SS + sidx + 32 * j) = hn; }
    }
    __syncthreads();
    if (tid < 64) { const int hh = tid >> 3, t = tid & 7; float sum = 0.f;
#pragma unroll
        for (int w = 0; w < 8; ++w) sum += sSS[tid * 8 + w];
        YSS[(size_t)(rbase + t) * 32 + g * 8 + hh] = sum; }
    __syncthreads();
}

__device__ __forceinline__ void pool_prompt(const Params& p, unsigned char* smem, int b, int rt, int g) {
    const int tid = threadIdx.x;
    bf16_t* tile = (bf16_t*)smem;
    const bf16_t* PROJ = (const bf16_t*)(p.ws + W_PROJ);
    bf16_t* POOLED = (bf16_t*)(p.ws + W_XN);
    const int r0 = b * TP + rt * 64;
    for (int v = tid; v < 79 * 64; v += 512) { const int k = v >> 6, cv = v & 63; int rr = r0 - 15 + k; rr = rr < 0 ? 0 : rr;
        *(u32x4*)(tile + k * 512 + cv * 8) = *(const u32x4*)(PROJ + (size_t)rr * NPROJ + C_U + g * 512 + cv * 8); }
    __syncthreads();
    const int w = 2 << g, c = tid;
    float s = 0.f;
    for (int k = 1; k < w; ++k) s += bf2f(tile[(15 - k) * 512 + c]);
    for (int i = 0; i < 64; ++i) {
        const int tseq = rt * 64 + i; int cnt = tseq - PADR + 1; cnt = cnt > w ? w : cnt; cnt = cnt < 1 ? 1 : cnt;
        const float cur = bf2f(tile[(15 + i) * 512 + c]);
        s += cur;
        POOLED[(size_t)(r0 + i) * DM + g * 512 + c] = f2bf(s / (float)cnt - cur);
        s -= bf2f(tile[(15 + i - (w - 1)) * 512 + c]);
        if (tseq >= TP - 15) p.out[O_PP + ((size_t)b * 15 + (tseq - (TP - 15))) * DM + g * 512 + c] = cur;
    }
    __syncthreads();
}
__device__ __forceinline__ void pool_sample(const Params& p, int s, int g) {
    const int col = g * 512 + threadIdx.x, w = 2 << g;
    const bf16_t* PROJ = (const bf16_t*)(p.ws + W_PROJ);
    bf16_t* POOLED = (bf16_t*)(p.ws + W_XN);
    float v[23];
#pragma unroll
    for (int j = 0; j < 15; ++j) v[j] = p.state_pool[((size_t)s * 15 + j) * DM + col];
#pragma unroll
    for (int t = 0; t < 8; ++t) v[15 + t] = bf2f(PROJ[(size_t)(ROWS_P + s * 8 + t) * NPROJ + C_U + col]);
    const float inv = 1.0f / (float)w;
#pragma unroll
    for (int t = 0; t < 8; ++t) { float sum = 0.f;
#pragma unroll
        for (int k = 0; k < 16; ++k) sum += (k < w) ? v[15 + t - k] : 0.f;
        POOLED[(size_t)(ROWS_P + s * 8 + t) * DM + col] = f2bf(sum * inv - v[15 + t]); }
#pragma unroll
    for (int j = 0; j < 15; ++j) p.out[O_PS + ((size_t)s * 15 + j) * DM + col] = v[j + 8];
}

__device__ __forceinline__ void phase_ssd(const Params& p, unsigned char* smem) {
    const int G = gridDim.x, bid = blockIdx.x;
    const int nssd = G >= 256 ? 128 : (G / 2 > 0 ? G / 2 : 1);
    if (bid < nssd || G == 1) { for (int it = bid; it < 128; it += nssd) ssd_prompt(p, smem, it >> 5, it & 31); }
    if (bid >= nssd || G == 1) {
        const int ob = G == 1 ? 0 : bid - nssd, nob = G == 1 ? 1 : G - nssd;
        for (int it = ob; it < 512 + 544 + 512 + 1; it += nob) {
            if (it < 512) ssd_sample(p, smem, it >> 2, it & 3);
            else if (it < 1056) { const int j = it - 512; pool_prompt(p, smem, j / 136, (j % 136) >> 2, j & 3); }
            else if (it < 1568) { const int j = it - 1056; pool_sample(p, j >> 2, j & 3); }
            else { const bf16_t* PROJ = (const bf16_t*)(p.ws + W_PROJ);
                for (int e = threadIdx.x; e < 4 * 3 * CONVD; e += 512) { const int b = e / (3 * CONVD), r = e % (3 * CONVD), j = r / CONVD, cc = r % CONVD;
                    p.out[O_CP + e] = bf2f(PROJ[(size_t)(b * TP + TP - 3 + j) * NPROJ + C_XBC + cc]); } }
        }
    }
}

__device__ __forceinline__ void phase_ynorm(const Params& p) {
    const int wid = threadIdx.x >> 6, lane = threadIdx.x & 63;
    bf16_t* A2 = (bf16_t*)(p.ws + W_A2); const float* YSS = (const float*)(p.ws + W_YSS);
    for (int it = blockIdx.x * 8 + wid; it < TROWS * 4; it += gridDim.x * 8) {
        const int row = it >> 2, g = it & 3;
        const f32x4 s0 = *(const f32x4*)(YSS + (size_t)row * 32 + g * 8), s1 = *(const f32x4*)(YSS + (size_t)row * 32 + g * 8 + 4);
        const float ss = s0[0] + s0[1] + s0[2] + s0[3] + s1[0] + s1[1] + s1[2] + s1[3];
        const float rs = rsqrtf(ss * (1.0f / 512.0f) + EPS);
        bf16_t* ptr = A2 + (size_t)row * 4096 + g * 512 + lane * 8;
        const u32x4 v = *(const u32x4*)ptr;
        const f32x4 w0 = *(const f32x4*)(p.ssd_norm_w + g * 512 + lane * 8), w1 = *(const f32x4*)(p.ssd_norm_w + g * 512 + lane * 8 + 4);
        u32x4 o; o.x = pk2(bflo(v.x) * rs * w0[0], bfhi(v.x) * rs * w0[1]); o.y = pk2(bflo(v.y) * rs * w0[2], bfhi(v.y) * rs * w0[3]);
        o.z = pk2(bflo(v.z) * rs * w1[0], bfhi(v.z) * rs * w1[1]); o.w = pk2(bflo(v.w) * rs * w1[2], bfhi(v.w) * rs * w1[3]);
        *(u32x4*)ptr = o;
    }
}
__device__ __forceinline__ void phase_final(const Params& p) {
    const int wid = threadIdx.x >> 6, lane = threadIdx.x & 63;
    const float* RSS = (const float*)(p.ws + W_RSS);
    for (int r = blockIdx.x * 8 + wid; r < TROWS; r += gridDim.x * 8) {
        float* dst = row_dst(p, r); if (!dst) continue;
        float ss = lane < 32 ? RSS[(size_t)r * 32 + lane] : 0.f;
#pragma unroll
        for (int o = 32; o >= 1; o >>= 1) ss += __shfl_xor(ss, o);
        const float rs = rsqrtf(ss * (1.0f / DM) + EPS);
#pragma unroll
        for (int i = 0; i < 8; ++i) { f32x4 v = ((f32x4*)dst)[lane + 64 * i]; const f32x4 w = ((const f32x4*)p.final_norm_w)[lane + 64 * i];
            v[0] *= rs * w[0]; v[1] *= rs * w[1]; v[2] *= rs * w[2]; v[3] *= rs * w[3]; ((f32x4*)dst)[lane + 64 * i] = v; }
    }
}

__global__ void __launch_bounds__(512, 2) fwd_megakernel(Params p) {
    extern __shared__ __attribute__((aligned(16))) unsigned char shm[];
    cg::grid_group grid = cg::this_grid();
    LAS unsigned char* lds = (LAS unsigned char*)shm;
    bf16_t* XN = (bf16_t*)(p.ws + W_XN); bf16_t* PROJ = (bf16_t*)(p.ws + W_PROJ); bf16_t* A2 = (bf16_t*)(p.ws + W_A2);
    phase_prep(p, (float*)shm);
    grid.sync();
    { GemmD g{XN, (const bf16_t*)(p.ws + W_WINT), DM, DM, DM, TROWS / BM, NPROJ / BM, 0, 0, 1};
      EpiProj e{PROJ, (float*)(p.ws + W_DTRAW)};
      gemm_phase(lds, g, e); }
    grid.sync();
    phase_ssd(p, shm);
    grid.sync();
    { GemmD g{XN  , (const bf16_t*)(p.ws + W_WMIX), DM, 512, 512, TROWS / BM, DM / BM, 2, 512, 1};
      EpiMix e{PROJ, A2, p.pool_mix_b, p.pool_scale};
      gemm_phase(lds, g, e); }
    phase_ynorm(p);
    grid.sync();
    { GemmD g{A2, (const bf16_t*)(p.ws + W_WSP), 4096, 4096, 2048, TROWS / BM, DM / BM, 0, 0, 2};
      EpiMerged e{PROJ, XN  };
      gemm_phase(lds, g, e); }
    grid.sync();
    { GemmD g{XN  , (const bf16_t*)(p.ws + W_WOUT), DM, DM, DM, TROWS / BM, DM / BM, 0, 0, 1};
      EpiOut e{p, (float*)(p.ws + W_RSS)};
      gemm_phase(lds, g, e); }
    grid.sync();
    phase_final(p);
}

extern "C" void kernel_launch(void* const* d_in, const int* in_sizes, int n_in, void* d_out, int out_size, void* d_ws, size_t ws_size, hipStream_t stream) {
    static int grid_blocks = 0;
    if (!grid_blocks) {
        int dev = 0, cus = 0, per_cu = 0;
        hipGetDevice(&dev);
        hipDeviceGetAttribute(&cus, hipDeviceAttributeMultiprocessorCount, dev);
        hipFuncSetAttribute((const void*)fwd_megakernel, hipFuncAttributeMaxDynamicSharedMemorySize, LDS_BYTES);
        hipOccupancyMaxActiveBlocksPerMultiprocessor(&per_cu, fwd_megakernel, 512, LDS_BYTES);
        if (per_cu > 1) per_cu = 1;
        grid_blocks = cus * per_cu;
        grid_blocks &= ~7;
    }
    if (ws_size < W_END || grid_blocks <= 0) { fprintf(stderr, "workspace too small or no occupancy (%zu, %d)\n", ws_size, grid_blocks); return; }
    Params p{};
    const float** f = (const float**)&p;
    for (int i = 0; i < 21; ++i) f[i] = (const float*)d_in[i];
    p.out = (float*)d_out; p.ws = (unsigned char*)d_ws;
    void* args[] = {&p};
    hipError_t e = hipLaunchCooperativeKernel((void*)fwd_megakernel, dim3(grid_blocks), dim3(512), args, LDS_BYTES, stream);
    if (e != hipSuccess) fprintf(stderr, "cooperative launch failed: %s (grid %d)\n", hipGetErrorString(e), grid_blocks);
}
```

```cpp
#include <hip/hip_runtime.h>
#include <hip/hip_cooperative_groups.h>
#include <cstdio>
namespace cg = cooperative_groups;

#define LAS __attribute__((address_space(3)))
typedef unsigned short bf16_t;
typedef short bf16x8 __attribute__((ext_vector_type(8)));
typedef float f32x4 __attribute__((ext_vector_type(4)));
typedef unsigned u32x4 __attribute__((ext_vector_type(4)));
typedef unsigned u32x2 __attribute__((ext_vector_type(2)));

constexpr int DM = 2048;
constexpr int TP = 2176;
constexpr int PADR = 112;
constexpr int ROWS_P = 4 * TP;
constexpr int TROWS = ROWS_P + 1024;
constexpr int NPROJ = 13568;
constexpr int C_Z = 0, C_XBC = 2048, C_ZP = 5120, C_U = 7168, C_GS = 9216, C_GP = 11264, C_DT = 13312;
constexpr int CONVD = 3072;
constexpr float EPS = 1e-6f;
constexpr size_t O_YP = 0, O_YS = 16777216, O_CP = 18874368, O_SP = 18911232, O_PP = 19959808, O_CS = 20082688, O_SS = 21262336, O_PS = 54816768;
constexpr size_t W_XN = 0;
constexpr size_t W_WINT = 39845888;
constexpr size_t W_WSP = W_WINT + 55574528;
constexpr size_t W_WMIX = W_WSP + 16777216;
constexpr size_t W_WOUT = W_WMIX + 2097152;
constexpr size_t W_PROJ = W_WOUT + 8388608;
constexpr size_t W_DTRAW = W_PROJ + 263979008;
constexpr size_t W_A2 = W_DTRAW + 1245184;
constexpr size_t W_YSS = W_A2 + 79691776;
constexpr size_t W_RSS = W_YSS + 1245184;
constexpr size_t W_XACT = W_RSS + 1245184;
constexpr size_t W_AC = W_XACT + 59768832;
constexpr size_t W_BAR = W_AC + 1114112;
constexpr size_t W_DT = W_BAR + 16384;
constexpr size_t W_END = W_DT + 1245184;
constexpr int LDS_BYTES = 147456;

struct Params {
    const float *x_prompt, *x_sample, *state_conv, *state_ssm, *state_pool, *meta, *norm_w, *w_in, *conv_w, *conv_b, *dt_bias, *a_log, *d_skip,
        *ssd_norm_w, *w_proj_ssd, *pool_mix_w, *pool_mix_b, *pool_scale, *w_proj_pool, *w_out, *final_norm_w;
    float* out;
    unsigned char* ws;
};

__device__ __forceinline__ int tid_opaque() { int t = threadIdx.x; asm volatile("" : "+v"(t)); return t; }
__device__ __forceinline__ float bf2f(unsigned b) { return __uint_as_float(b << 16); }
__device__ __forceinline__ float bflo(unsigned w) { return __uint_as_float(w << 16); }
__device__ __forceinline__ float bfhi(unsigned w) { return __uint_as_float(w & 0xffff0000u); }
__device__ __forceinline__ unsigned pk2(float lo, float hi) { unsigned r; asm("v_cvt_pk_bf16_f32 %0, %1, %2" : "=v"(r) : "v"(lo), "v"(hi)); return r; }
__device__ __forceinline__ bf16_t f2bf(float f) { return (bf16_t)(pk2(f, 0.f) & 0xffffu); }
__device__ __forceinline__ float sigmoidf_(float x) { return __builtin_amdgcn_rcpf(1.0f + __expf(-x)); }
__device__ __forceinline__ float siluf_(float x) { return x * __builtin_amdgcn_rcpf(1.0f + __expf(-x)); }
__device__ __forceinline__ float softplusf_(float x) { return x > 20.f ? x : log1pf(__expf(x)); }
__device__ __forceinline__ const float* row_src(const Params& p, int r) {
    if (r < ROWS_P) { const int b = r / TP, t = r - b * TP;
        if (t < PADR) return nullptr;
        if (t < 128) return p.meta + (size_t)(t - PADR) * DM;
        return p.x_prompt + ((size_t)b * 2048 + (t - 128)) * DM; }
    return p.x_sample + (size_t)(r - ROWS_P) * DM;
}
__device__ __forceinline__ float* row_dst(const Params& p, int r) {
    if (r < ROWS_P) { const int b = r / TP, t = r - b * TP;
        if (t < 128) return nullptr;
        return p.out + O_YP + ((size_t)b * 2048 + (t - 128)) * DM; }
    return p.out + O_YS + (size_t)(r - ROWS_P) * DM;
}

constexpr int BM = 256, BK = 64, HALF = 128, HTB = HALF * BK * 2, NXCD = 8, WGM = 8;
__device__ __forceinline__ int lds_byte(int r, int c) { const int st = (r >> 4) * 2 + (c >> 5), rr = r & 15, cc = c & 31, ob = rr * 64 + cc * 2; return st * 1024 + (ob ^ (((ob >> 9) & 1) << 5)); }
__device__ __forceinline__ void stage_rc(int b, int& R, int& C) { const int st = b / 1024, sb = b % 1024, swz = sb ^ (((sb >> 9) & 1) << 5); R = (st >> 1) * 16 + swz / 64; C = (st & 1) * 32 + (swz % 64) / 2; }
__device__ __forceinline__ int perm32(int rho) { const int n = rho >> 4, i = rho & 15; return 8 * (i >> 2) + 4 * n + (i & 3); }
struct Unit { int pm, pn, sub; };
struct GemmD { const bf16_t* A; const bf16_t* Bt; int lda, ldb, K, nM, nN, a_kdiv, a_kstride, nsub, pm_off, vbid, vG, t0, tmax, linear; };
__device__ __forceinline__ bool unit_next(const GemmD& g, int i, Unit& u) {
    u.sub = g.nsub == 2 ? (i & 1) : 0; if (g.nsub == 2) i >>= 1;
    const int nwg = g.nM * g.nN; const long L = (long)g.t0 + (long)i * g.vG + g.vbid; if (L >= g.tmax) return false;
    if (g.linear) { u.pm = g.pm_off + (int)L / g.nN; u.pn = (int)L % g.nN; return true; }
    int wgid = (int)L; { const int q = nwg / NXCD, r = nwg % NXCD, xcd = wgid % NXCD, off = wgid / NXCD; wgid = (xcd < r ? xcd * (q + 1) : r * (q + 1) + (xcd - r) * q) + off; }
    const int nig = WGM * g.nN, gid = wgid / nig, fm = gid * WGM, gsz = (g.nM - fm) < WGM ? (g.nM - fm) : WGM;
    u.pm = g.pm_off + fm + ((wgid % nig) % gsz); u.pn = (wgid % nig) / gsz; return true;
}
__device__ __forceinline__ const char* unit_a(const GemmD& g, const Unit& u) { return (const char*)(g.A + (size_t)u.pm * BM * g.lda + (g.a_kdiv ? (u.pn / g.a_kdiv) * g.a_kstride : 0) + u.sub * g.K); }
__device__ __forceinline__ const char* unit_b(const GemmD& g, const Unit& u) { return (const char*)(g.Bt + (size_t)u.pn * BM * g.ldb + u.sub * g.K); }

template <class Epi>
__device__ __forceinline__ void gemm_phase(LAS unsigned char* lds, const GemmD g, const Epi& E) {
    const int tid = tid_opaque(), wid = __builtin_amdgcn_readfirstlane(tid >> 6), lane = tid & 63, wr = wid >> 2, wc = wid & 3, fr = lane & 15, fq = lane >> 4;
    const int K = g.K, nt = K / BK;
    unsigned voffA[2], voffB[2];
#pragma unroll
    for (int i = 0; i < 2; ++i) { int R, C; stage_rc(tid * 16 + i * 8192, R, C); const int Rb = (R & ~31) + perm32(R & 31);
        voffA[i] = (unsigned)(R * g.lda + C) * 2u; voffB[i] = (unsigned)(Rb * g.ldb + C) * 2u; }
    const size_t kstep = (size_t)(BK * 2);
    const size_t hstepA = (size_t)HALF * g.lda * 2, hstepB = (size_t)HALF * g.ldb * 2;
    const unsigned ldsw = (unsigned)wid * 1024u;
    const int aoff = lds_byte(wr * 64 + fr, fq * 8), boff = lds_byte(wc * 32 + fr, fq * 8);
#define PG8_SA(b, h) (((b) * 2 + (h)) * HTB)
#define PG8_SB(b, h) ((4 + (b) * 2 + (h)) * HTB)
#define PG8_STAGE(bufoff, gbase, voff) do { _Pragma("unroll") for (int _i = 0; _i < 2; ++_i) \
        __builtin_amdgcn_global_load_lds((const unsigned*)((const char*)(gbase) + (voff)[_i]), (LAS unsigned*)(lds + (bufoff) + ldsw + _i * 8192), 16, 0, 0); } while (0)
#define PG8_LDA(dst, b, h) do { _Pragma("unroll") for (int m = 0; m < 4; ++m) _Pragma("unroll") for (int k = 0; k < 2; ++k) dst[m][k] = *(const LAS bf16x8*)(lds + PG8_SA(b, h) + aoff + m * 2048 + k * 1024); } while (0)
#define PG8_LDB(dst, b, h) do { _Pragma("unroll") for (int n = 0; n < 2; ++n) _Pragma("unroll") for (int k = 0; k < 2; ++k) dst[n][k] = *(const LAS bf16x8*)(lds + PG8_SB(b, h) + boff + n * 2048 + k * 1024); } while (0)
#define PG8_MMA(ai, bj, At, Bt) do { __builtin_amdgcn_s_setprio(1); _Pragma("unroll") for (int m = 0; m < 4; ++m) _Pragma("unroll") for (int n = 0; n < 2; ++n) _Pragma("unroll") for (int k = 0; k < 2; ++k) \
        acc[ai][bj][m][n] = __builtin_amdgcn_mfma_f32_16x16x32_bf16(Bt[n][k], At[m][k], acc[ai][bj][m][n], 0, 0, 0); __builtin_amdgcn_s_setprio(0); } while (0)
#define PG8_WAIT_V(n) asm volatile("s_waitcnt vmcnt(" #n ")" ::: "memory")
#define PG8_WAIT_L(n) asm volatile("s_waitcnt lgkmcnt(" #n ")" ::: "memory")
#define PG8_BAR __builtin_amdgcn_s_barrier()
#define PG8_SCHED __builtin_amdgcn_sched_barrier(0)
    Unit cur, nxt; int ui = 0;
    if (!unit_next(g, 0, cur)) return;
    f32x4 acc[2][2][4][2];
#pragma unroll
    for (int a = 0; a < 2; ++a)
#pragma unroll
        for (int b = 0; b < 2; ++b)
#pragma unroll
            for (int m = 0; m < 4; ++m)
#pragma unroll
                for (int n = 0; n < 2; ++n) acc[a][b][m][n] = (f32x4){0.f, 0.f, 0.f, 0.f};
    bf16x8 At[4][2], B0[2][2], B1[2][2];
    const char* cA = unit_a(g, cur); const char* cB = unit_b(g, cur);
    PG8_STAGE(PG8_SB(0, 0), cB, voffB); PG8_STAGE(PG8_SA(0, 0), cA, voffA); PG8_STAGE(PG8_SB(0, 1), cB + hstepB, voffB); PG8_STAGE(PG8_SA(0, 1), cA + hstepA, voffA);
    if (wr == 1) PG8_BAR;
    PG8_WAIT_V(4); PG8_BAR;
    PG8_STAGE(PG8_SB(1, 0), cB + kstep, voffB); PG8_STAGE(PG8_SA(1, 0), cA + kstep, voffA); PG8_STAGE(PG8_SB(1, 1), cB + hstepB + kstep, voffB);
    PG8_WAIT_V(6); PG8_BAR;
    for (;;) {
        const bool has_next = unit_next(g, ui + 1, nxt);
        const char* nA = has_next ? unit_a(g, nxt) : cA; const char* nB = has_next ? unit_b(g, nxt) : cB;
#define PG8_KITER(t) do { \
            const bool last = ((t) == nt - 2); \
            const char* a1 = cA + (size_t)((t) + 1) * kstep; \
            const char* a2 = last ? nA : cA + (size_t)((t) + 2) * kstep; const char* b2 = last ? nB : cB + (size_t)((t) + 2) * kstep; \
            const char* a3 = a2 + kstep; const char* b3 = b2 + kstep; \
            PG8_LDB(B0, 0, 0); PG8_SCHED; PG8_LDA(At, 0, 0); PG8_STAGE(PG8_SA(1, 1), a1 + hstepA, voffA); \
            PG8_WAIT_L(8); PG8_BAR; PG8_WAIT_L(0); PG8_MMA(0, 0, At, B0); PG8_BAR; PG8_SCHED; \
            PG8_LDB(B1, 0, 1); PG8_STAGE(PG8_SB(0, 0), b2, voffB); \
            PG8_BAR; PG8_WAIT_L(0); PG8_MMA(0, 1, At, B1); PG8_BAR; \
            PG8_LDA(At, 0, 1); PG8_STAGE(PG8_SA(0, 0), a2, voffA); \
            PG8_BAR; PG8_WAIT_L(0); PG8_MMA(1, 0, At, B0); PG8_BAR; PG8_SCHED; \
            PG8_STAGE(PG8_SB(0, 1), b2 + hstepB, voffB); \
            PG8_WAIT_V(6); PG8_BAR; PG8_MMA(1, 1, At, B1); PG8_BAR; \
            PG8_LDB(B0, 1, 0); PG8_SCHED; PG8_LDA(At, 1, 0); PG8_STAGE(PG8_SA(0, 1), a2 + hstepA, voffA); \
            PG8_WAIT_L(8); PG8_BAR; PG8_WAIT_L(0); PG8_MMA(0, 0, At, B0); PG8_BAR; PG8_SCHED; \
            PG8_LDB(B1, 1, 1); PG8_STAGE(PG8_SB(1, 0), b3, voffB); \
            PG8_BAR; PG8_WAIT_L(0); PG8_MMA(0, 1, At, B1); PG8_BAR; \
            PG8_LDA(At, 1, 1); PG8_STAGE(PG8_SA(1, 0), a3, voffA); \
            PG8_BAR; PG8_WAIT_L(0); PG8_MMA(1, 0, At, B0); PG8_BAR; PG8_SCHED; \
            PG8_STAGE(PG8_SB(1, 1), b3 + hstepB, voffB); \
            PG8_WAIT_V(6); PG8_BAR; PG8_MMA(1, 1, At, B1); PG8_BAR; } while (0)
        for (int t = 0; t < nt; t += 2) PG8_KITER(t);
#undef PG8_KITER
        bool keep = false;
        if constexpr (Epi::MID) { if (cur.sub == 0) { E.mid(acc, cur, wr, wc, fr, fq); keep = true; } else E(acc, cur, wr, wc, fr, fq); }
        else E(acc, cur, wr, wc, fr, fq);
        if (!has_next) break;
        cur = nxt; cA = nA; cB = nB; ++ui;
        if (keep) continue;
#pragma unroll
        for (int a = 0; a < 2; ++a)
#pragma unroll
            for (int b = 0; b < 2; ++b)
#pragma unroll
                for (int m = 0; m < 4; ++m)
#pragma unroll
                    for (int n = 0; n < 2; ++n) acc[a][b][m][n] = (f32x4){0.f, 0.f, 0.f, 0.f};
    }
    PG8_WAIT_V(0);
    if (wr == 0) PG8_BAR;
    PG8_BAR;
#undef PG8_SA
#undef PG8_SB
#undef PG8_STAGE
#undef PG8_LDA
#undef PG8_LDB
#undef PG8_MMA
#undef PG8_WAIT_V
#undef PG8_WAIT_L
#undef PG8_BAR
#undef PG8_SCHED
}

struct EpiProj {
    static constexpr bool MID = false;
    bf16_t* proj; float* dtraw;
    __device__ __forceinline__ void mid(f32x4 (&)[2][2][4][2], const Unit&, int, int, int, int) const {}
    __device__ __forceinline__ void operator()(const f32x4 (&acc)[2][2][4][2], const Unit& u, int wr, int wc, int fr, int fq) const {
        const int row0 = u.pm * BM + wr * 64 + fr, col0 = u.pn * BM + wc * 32 + 8 * fq;
        const bool sig = (u.pn >= 36 && u.pn < 52), isdt = (u.pn == 52);
#pragma unroll
        for (int ai = 0; ai < 2; ++ai)
#pragma unroll
            for (int m = 0; m < 4; ++m) { const int row = row0 + ai * HALF + m * 16;
#pragma unroll
                for (int bj = 0; bj < 2; ++bj) { const f32x4 v0 = acc[ai][bj][m][0], v1 = acc[ai][bj][m][1]; const int col = col0 + bj * HALF;
                    if (sig) {
                        const int c = (col - C_GS) >> 1;
                        float ra[4], gp[4];
#pragma unroll
                        for (int j = 0; j < 4; ++j) { const float ea = __expf(-fminf(fmaxf(v0[j], -30.f), 30.f)), eb = __expf(-fminf(fmaxf(v1[j], -30.f), 30.f)); gp[j] = __builtin_amdgcn_rcpf(1.0f + eb); ra[j] = (1.0f + eb) * __builtin_amdgcn_rcpf(1.0f + ea); }
                        u32x2 wr_, wg; wr_.x = pk2(ra[0], ra[1]); wr_.y = pk2(ra[2], ra[3]); wg.x = pk2(gp[0], gp[1]); wg.y = pk2(gp[2], gp[3]);
                        *(u32x2*)(proj + (size_t)row * NPROJ + C_GS + c) = wr_;
                        *(u32x2*)(proj + (size_t)row * NPROJ + C_GP + c) = wg;
                    } else {
                        u32x4 w; w.x = pk2(v0[0], v0[1]); w.y = pk2(v0[2], v0[3]); w.z = pk2(v1[0], v1[1]); w.w = pk2(v1[2], v1[3]);
                        *(u32x4*)(proj + (size_t)row * NPROJ + col) = w;
                        if (isdt && col < C_DT + 32) { float* d = dtraw + (size_t)row * 32 + (col - C_DT); *(f32x4*)d = v0; *(f32x4*)(d + 4) = v1; } } } }
    }
};
struct EpiMix {
    static constexpr bool MID = false;
    const bf16_t* proj; bf16_t* a2; const float* bias; const float* scale;
    __device__ __forceinline__ void mid(f32x4 (&)[2][2][4][2], const Unit&, int, int, int, int) const {}
    __device__ __forceinline__ void operator()(const f32x4 (&acc)[2][2][4][2], const Unit& u, int wr, int wc, int fr, int fq) const {
        const int row0 = u.pm * BM + wr * 64 + fr, col0 = u.pn * BM + wc * 32 + 8 * fq;
#pragma unroll
        for (int bj = 0; bj < 2; ++bj) { const int col = col0 + bj * HALF;
            const f32x4 b0 = *(const f32x4*)(bias + col), b1 = *(const f32x4*)(bias + col + 4), s0 = *(const f32x4*)(scale + col), s1 = *(const f32x4*)(scale + col + 4);
#pragma unroll
            for (int ai = 0; ai < 2; ++ai)
#pragma unroll
                for (int m = 0; m < 4; ++m) { const int row = row0 + ai * HALF + m * 16;
                    const u32x4 z = __builtin_nontemporal_load((const u32x4*)(proj + (size_t)row * NPROJ + C_ZP + col));
                    f32x4 v0 = (acc[ai][bj][m][0] + b0) * s0, v1 = (acc[ai][bj][m][1] + b1) * s1;
                    v0[0] *= siluf_(bflo(z.x)); v0[1] *= siluf_(bfhi(z.x)); v0[2] *= siluf_(bflo(z.y)); v0[3] *= siluf_(bfhi(z.y));
                    v1[0] *= siluf_(bflo(z.z)); v1[1] *= siluf_(bfhi(z.z)); v1[2] *= siluf_(bflo(z.w)); v1[3] *= siluf_(bfhi(z.w));
                    u32x4 w; w.x = pk2(v0[0], v0[1]); w.y = pk2(v0[2], v0[3]); w.z = pk2(v1[0], v1[1]); w.w = pk2(v1[2], v1[3]);
                    *(u32x4*)(a2 + (size_t)row * 4096 + 2048 + col) = w; } }
    }
};
struct EpiMerged {
    static constexpr bool MID = true;
    const bf16_t* proj; bf16_t* merged;
    __device__ __forceinline__ void mid(f32x4 (&acc)[2][2][4][2], const Unit& u, int wr, int wc, int fr, int fq) const {
        const int row0 = u.pm * BM + wr * 64 + fr, col0 = u.pn * BM + wc * 32 + 8 * fq;
        u32x4 rv[2][4][2];
#pragma unroll
        for (int ai = 0; ai < 2; ++ai)
#pragma unroll
            for (int m = 0; m < 4; ++m) { const bf16_t* rp = proj + (size_t)(row0 + ai * HALF + m * 16) * NPROJ + C_GS + col0; rv[ai][m][0] = __builtin_nontemporal_load((const u32x4*)(rp)); rv[ai][m][1] = __builtin_nontemporal_load((const u32x4*)(rp + HALF)); }
#pragma unroll
        for (int ai = 0; ai < 2; ++ai)
#pragma unroll
            for (int m = 0; m < 4; ++m)
#pragma unroll
                for (int bj = 0; bj < 2; ++bj) { const u32x4 r = rv[ai][m][bj];
                    acc[ai][bj][m][0] *= (f32x4){bflo(r.x), bfhi(r.x), bflo(r.y), bfhi(r.y)}; acc[ai][bj][m][1] *= (f32x4){bflo(r.z), bfhi(r.z), bflo(r.w), bfhi(r.w)}; }
    }
    __device__ __forceinline__ void operator()(const f32x4 (&acc)[2][2][4][2], const Unit& u, int wr, int wc, int fr, int fq) const {
        const int row0 = u.pm * BM + wr * 64 + fr, col0 = u.pn * BM + wc * 32 + 8 * fq;
#pragma unroll
        for (int ai = 0; ai < 2; ++ai)
#pragma unroll
            for (int m = 0; m < 4; ++m) { const int row = row0 + ai * HALF + m * 16;
#pragma unroll
                for (int bj = 0; bj < 2; ++bj) { const int col = col0 + bj * HALF;
                    const u32x4 gp = __builtin_nontemporal_load((const u32x4*)(proj + (size_t)row * NPROJ + C_GP + col));
                    const f32x4 v0 = acc[ai][bj][m][0], v1 = acc[ai][bj][m][1];
                    u32x4 w; w.x = pk2(v0[0] * bflo(gp.x), v0[1] * bfhi(gp.x)); w.y = pk2(v0[2] * bflo(gp.y), v0[3] * bfhi(gp.y));
                    w.z = pk2(v1[0] * bflo(gp.z), v1[1] * bfhi(gp.z)); w.w = pk2(v1[2] * bflo(gp.w), v1[3] * bfhi(gp.w));
                    *(u32x4*)(merged + (size_t)row * DM + col) = w; } }
    }
};
struct EpiHalf {
    static constexpr bool MID = false;
    const bf16_t* proj; float* F; int which;
    __device__ __forceinline__ void mid(f32x4 (&)[2][2][4][2], const Unit&, int, int, int, int) const {}
    __device__ __forceinline__ void operator()(const f32x4 (&acc)[2][2][4][2], const Unit& u, int wr, int wc, int fr, int fq) const {
        const int row0 = u.pm * BM + wr * 64 + fr, col0 = u.pn * BM + wc * 32 + 8 * fq;
#pragma unroll
        for (int ai = 0; ai < 2; ++ai)
#pragma unroll
            for (int m = 0; m < 4; ++m) { const int row = row0 + ai * HALF + m * 16;
#pragma unroll
                for (int bj = 0; bj < 2; ++bj) { const int col = col0 + bj * HALF;
                    const u32x4 gp = __builtin_nontemporal_load((const u32x4*)(proj + (size_t)row * NPROJ + C_GP + col));
                    f32x4 f0 = (f32x4){bflo(gp.x), bfhi(gp.x), bflo(gp.y), bfhi(gp.y)}, f1 = (f32x4){bflo(gp.z), bfhi(gp.z), bflo(gp.w), bfhi(gp.w)};
                    if (which == 0) { const u32x4 r = *(const u32x4*)(proj + (size_t)row * NPROJ + C_GS + col);
                        f0 *= (f32x4){bflo(r.x), bfhi(r.x), bflo(r.y), bfhi(r.y)}; f1 *= (f32x4){bflo(r.z), bfhi(r.z), bflo(r.w), bfhi(r.w)}; }
                    float* d = F + (size_t)(row - 8192) * DM + col;
                    *(f32x4*)d = acc[ai][bj][m][0] * f0; *(f32x4*)(d + 4) = acc[ai][bj][m][1] * f1; } }
    }
};
struct EpiOut {
    static constexpr bool MID = false;
    Params p; float* rss;
    __device__ __forceinline__ void mid(f32x4 (&)[2][2][4][2], const Unit&, int, int, int, int) const {}
    __device__ __forceinline__ void operator()(const f32x4 (&acc)[2][2][4][2], const Unit& u, int wr, int wc, int fr, int fq) const {
        const int row0 = u.pm * BM + wr * 64 + fr, col0 = u.pn * BM + wc * 32 + 8 * fq;
#pragma unroll
        for (int ai = 0; ai < 2; ++ai)
#pragma unroll
            for (int m = 0; m < 4; ++m) { const int row = row0 + ai * HALF + m * 16;
                const float* src = row_src(p, row); float* dst = row_dst(p, row); float ss = 0.f;
                if (dst) {
#pragma unroll
                    for (int bj = 0; bj < 2; ++bj) { const int col = col0 + bj * HALF;
                        const f32x4 h0 = __builtin_nontemporal_load((const f32x4*)(src + col)), h1 = __builtin_nontemporal_load((const f32x4*)(src + col + 4));
                        const f32x4 v0 = acc[ai][bj][m][0] + h0, v1 = acc[ai][bj][m][1] + h1;
                        *(f32x4*)(dst + col) = v0; *(f32x4*)(dst + col + 4) = v1;
                        ss += v0[0] * v0[0] + v0[1] * v0[1] + v0[2] * v0[2] + v0[3] * v0[3] + v1[0] * v1[0] + v1[1] * v1[1] + v1[2] * v1[2] + v1[3] * v1[3]; } }
                ss += __shfl_xor(ss, 16); ss += __shfl_xor(ss, 32);
                if (fq == 0) rss[(size_t)row * 32 + u.pn * 4 + wc] = ss; }
    }
};

__device__ __forceinline__ int win_src_col(int n) {
    if (n < 5120) return n;
    if (n < C_GS) return n + 32;
    if (n < C_DT) { const int j = n - C_GS, k = j >> 3, wi = j & 7; return ((wi >> 2) ? 11296 : 9248) + 4 * k + (wi & 3); }
    if (n < C_DT + 32) return n - C_DT + 5120;
    return -1;
}
constexpr int TT_LD = 257;
struct TTile { const float* src; bf16_t* dst; int sld, dld, k0, n0, remap; };
__device__ __forceinline__ TTile tt_get(const Params& p, int it) {
    bf16_t* WINT = (bf16_t*)(p.ws + W_WINT); bf16_t* WSP = (bf16_t*)(p.ws + W_WSP); bf16_t* WMIX = (bf16_t*)(p.ws + W_WMIX); bf16_t* WOUT = (bf16_t*)(p.ws + W_WOUT);
    constexpr int NT_IN = 53 * 32, NT_SQ = 8 * 32;
    TTile t;
    if (it < NT_IN) { t = TTile{p.w_in, WINT, 13344, DM, (it & 31) * 64, (it >> 5) * 256, 1}; }
    else if (it < NT_IN + NT_SQ) { const int j = it - NT_IN; t = TTile{p.w_proj_ssd, WSP, DM, 4096, (j & 31) * 64, (j >> 5) * 256, 0}; }
    else if (it < NT_IN + 2 * NT_SQ) { const int j = it - NT_IN - NT_SQ; t = TTile{p.w_proj_pool, WSP + 2048, DM, 4096, (j & 31) * 64, (j >> 5) * 256, 0}; }
    else if (it < NT_IN + 3 * NT_SQ) { const int j = it - NT_IN - 2 * NT_SQ; t = TTile{p.w_out, WOUT, DM, DM, (j & 31) * 64, (j >> 5) * 256, 0}; }
    else { const int j = it - NT_IN - 3 * NT_SQ, gq = j >> 4, r = j & 15; t = TTile{p.pool_mix_w + (size_t)gq * 512 * 512, WMIX + (size_t)gq * 512 * 512, 512, 512, (r & 7) * 64, (r >> 3) * 256, 0}; }
    return t;
}
constexpr int TT_TOTAL = 53 * 32 + 3 * 8 * 32 + 64;
__device__ __forceinline__ void tt_load(const TTile& t, int tid, f32x4 (&v)[8]) {
    const int c4 = tid & 63, kb = tid >> 6; const int n = t.n0 + 4 * c4; const int sc = t.remap ? win_src_col(n) : n;
#pragma unroll
    for (int ps = 0; ps < 8; ++ps) { const int k = ps * 8 + kb; v[ps] = sc >= 0 ? __builtin_nontemporal_load((const f32x4*)(t.src + (size_t)(t.k0 + k) * t.sld + sc)) : (f32x4){0.f, 0.f, 0.f, 0.f}; }
}
__device__ __forceinline__ void phase_prep(const Params& p, float* tile) {
    const int tid = tid_opaque(), wid = tid >> 6, lane = tid & 63;
    bf16_t* XN = (bf16_t*)(p.ws + W_XN);
    for (int r = blockIdx.x * 8 + wid; r < TROWS; r += gridDim.x * 8) {
        const float* src = row_src(p, r); bf16_t* dst = XN + (size_t)r * DM;
        if (!src) {
#pragma unroll
            for (int i = 0; i < 4; ++i) *(u32x4*)(dst + (lane + 64 * i) * 8) = (u32x4){0u, 0u, 0u, 0u};
        } else {
            f32x4 v[8]; float ss = 0.f;
#pragma unroll
            for (int i = 0; i < 8; ++i) { v[i] = __builtin_nontemporal_load((const f32x4*)src + lane + 64 * i); ss += v[i][0] * v[i][0] + v[i][1] * v[i][1] + v[i][2] * v[i][2] + v[i][3] * v[i][3]; }
#pragma unroll
            for (int o = 32; o >= 1; o >>= 1) ss += __shfl_xor(ss, o);
            const float rs = rsqrtf(ss * (1.0f / DM) + EPS);
#pragma unroll
            for (int i = 0; i < 8; ++i) { const f32x4 w = ((const f32x4*)p.norm_w)[lane + 64 * i];
                u32x2 o; o.x = pk2(v[i][0] * rs * w[0], v[i][1] * rs * w[1]); o.y = pk2(v[i][2] * rs * w[2], v[i][3] * rs * w[3]);
                *(u32x2*)(dst + (lane + 64 * i) * 4) = o; }
        }
    }
    int it = blockIdx.x;
    if (it < TT_TOTAL) {
        TTile cur = tt_get(p, it); f32x4 v[8]; tt_load(cur, tid, v);
        for (;;) {
            { const int c4 = tid & 63, kb = tid >> 6;
#pragma unroll
                for (int ps = 0; ps < 8; ++ps) { float* d = tile + (ps * 8 + kb) * TT_LD + 4 * c4; d[0] = v[ps][0]; d[1] = v[ps][1]; d[2] = v[ps][2]; d[3] = v[ps][3]; } }
            __syncthreads();
            const int nit = it + gridDim.x; const bool more = nit < TT_TOTAL;
            const TTile nxt = tt_get(p, more ? nit : it);
            if (more) tt_load(nxt, tid, v);
            { const int kg = tid & 7, nb = tid >> 3;
#pragma unroll
                for (int i = 0; i < 4; ++i) { const int n = nb + 64 * i; float x[8];
#pragma unroll
                    for (int j = 0; j < 8; ++j) x[j] = tile[(kg * 8 + j) * TT_LD + n];
                    u32x4 w; w.x = pk2(x[0], x[1]); w.y = pk2(x[2], x[3]); w.z = pk2(x[4], x[5]); w.w = pk2(x[6], x[7]);
                    *(u32x4*)(cur.dst + (size_t)(cur.n0 + n) * cur.dld + cur.k0 + kg * 8) = w; } }
            __syncthreads();
            if (!more) break;
            cur = nxt; it = nit;
        }
    }
}

__device__ __forceinline__ void pool_prompt(const Params& p, unsigned char* smem, int b, int rt, int g) {
    const int tid = tid_opaque();
    bf16_t* tile = (bf16_t*)smem;
    const bf16_t* PROJ = (const bf16_t*)(p.ws + W_PROJ);
    bf16_t* POOLED = (bf16_t*)(p.ws + W_XN);
    const int r0 = b * TP + rt * 64;
#pragma unroll
    for (int v = tid; v < 79 * 64; v += 512) { const int k = v >> 6, cv = v & 63; int rr = r0 - 15 + k; rr = rr < 0 ? 0 : rr;
        *(u32x4*)(tile + k * 512 + cv * 8) = __builtin_nontemporal_load((const u32x4*)(PROJ + (size_t)rr * NPROJ + C_U + g * 512 + cv * 8)); }
    __syncthreads();
    const int w = 2 << g, c2 = tid & 255, hf = tid >> 8;
    const unsigned* tile32 = (const unsigned*)tile;
    float s0 = 0.f, s1 = 0.f;
    for (int k = 1; k < w; ++k) { const unsigned x = tile32[(15 + 32 * hf - k) * 256 + c2]; s0 += bflo(x); s1 += bfhi(x); }
#pragma unroll 8
    for (int i = 0; i < 32; ++i) {
        const int ri = 32 * hf + i, tseq = rt * 64 + ri; int cnt = tseq - PADR + 1; cnt = cnt > w ? w : cnt; cnt = cnt < 1 ? 1 : cnt;
        const unsigned cu = tile32[(15 + ri) * 256 + c2]; const float c0 = bflo(cu), c1 = bfhi(cu);
        s0 += c0; s1 += c1;
        const float inv = __builtin_amdgcn_rcpf((float)cnt);
        *(unsigned*)(POOLED + (size_t)(r0 + ri) * DM + g * 512 + 2 * c2) = pk2(s0 * inv - c0, s1 * inv - c1);
        const unsigned ou = tile32[(15 + ri - (w - 1)) * 256 + c2]; s0 -= bflo(ou); s1 -= bfhi(ou);
        if (tseq >= TP - 15) { float* d = p.out + O_PP + ((size_t)b * 15 + (tseq - (TP - 15))) * DM + g * 512 + 2 * c2; d[0] = c0; d[1] = c1; }
    }
    __syncthreads();
}
__device__ __forceinline__ void pool_sample(const Params& p, int s, int g) {
    const int col = g * 512 + tid_opaque(), w = 2 << g;
    const bf16_t* PROJ = (const bf16_t*)(p.ws + W_PROJ);
    bf16_t* POOLED = (bf16_t*)(p.ws + W_XN);
    float v[23];
#pragma unroll
    for (int j = 0; j < 15; ++j) v[j] = p.state_pool[((size_t)s * 15 + j) * DM + col];
#pragma unroll
    for (int t = 0; t < 8; ++t) v[15 + t] = bf2f(PROJ[(size_t)(ROWS_P + s * 8 + t) * NPROJ + C_U + col]);
    const float inv = 1.0f / (float)w;
#pragma unroll
    for (int t = 0; t < 8; ++t) { float sum = 0.f;
#pragma unroll
        for (int k = 0; k < 16; ++k) sum += (k < w) ? v[15 + t - k] : 0.f;
        POOLED[(size_t)(ROWS_P + s * 8 + t) * DM + col] = f2bf(sum * inv - v[15 + t]); }
#pragma unroll
    for (int j = 0; j < 15; ++j) p.out[O_PS + ((size_t)s * 15 + j) * DM + col] = v[j + 8];
}

__device__ __forceinline__ void phase_conv(const Params& p) {
    const bf16_t* PROJ = (const bf16_t*)(p.ws + W_PROJ);
    bf16_t* XACT = (bf16_t*)(p.ws + W_XACT);
    constexpr int NRUN = TROWS / 8, NCG = CONVD / 8, NRUN_P = ROWS_P / 8;
    const int tid = tid_opaque();
    struct Raw { u32x4 L[11]; };
    auto load_raw = [&](int item, Raw& r) {
        const int run = item / NCG, cc = (item - run * NCG) * 8, r0 = run * 8;
        const bool smp = run >= NRUN_P;
#pragma unroll
        for (int k = 0; k < 11; ++k) { int rr = r0 - 3 + k; rr = (rr < 0 || (smp && k < 3)) ? r0 : rr; r.L[k] = __builtin_nontemporal_load((const u32x4*)(PROJ + (size_t)rr * NPROJ + C_XBC + cc)); }
    };
    auto compute = [&](int item, const Raw& r) {
        const int run = item / NCG, cc = (item - run * NCG) * 8, r0 = run * 8;
        const bool smp = run >= NRUN_P; const int s = run - NRUN_P;
        const bool zero0 = (!smp && r0 < 3);
        float hv[3][8];
#pragma unroll
        for (int k = 0; k < 3; ++k) {
            if (smp) { const f32x4 a = *(const f32x4*)(p.state_conv + ((size_t)s * 3 + k) * CONVD + cc), b = *(const f32x4*)(p.state_conv + ((size_t)s * 3 + k) * CONVD + cc + 4);
                hv[k][0] = a[0]; hv[k][1] = a[1]; hv[k][2] = a[2]; hv[k][3] = a[3]; hv[k][4] = b[0]; hv[k][5] = b[1]; hv[k][6] = b[2]; hv[k][7] = b[3]; }
            else { const u32x4 L = r.L[k];
                hv[k][0] = bflo(L.x); hv[k][1] = bfhi(L.x); hv[k][2] = bflo(L.y); hv[k][3] = bfhi(L.y); hv[k][4] = bflo(L.z); hv[k][5] = bfhi(L.z); hv[k][6] = bflo(L.w); hv[k][7] = bfhi(L.w);
                if (zero0) {
#pragma unroll
                    for (int j = 0; j < 8; ++j) hv[k][j] = 0.f; } }
        }
        float w[4][8], bb[8];
#pragma unroll
        for (int k = 0; k < 4; ++k) { const f32x4 a = *(const f32x4*)(p.conv_w + k * CONVD + cc), b = *(const f32x4*)(p.conv_w + k * CONVD + cc + 4);
            w[k][0] = a[0]; w[k][1] = a[1]; w[k][2] = a[2]; w[k][3] = a[3]; w[k][4] = b[0]; w[k][5] = b[1]; w[k][6] = b[2]; w[k][7] = b[3]; }
        { const f32x4 a = *(const f32x4*)(p.conv_b + cc), b = *(const f32x4*)(p.conv_b + cc + 4); bb[0] = a[0]; bb[1] = a[1]; bb[2] = a[2]; bb[3] = a[3]; bb[4] = b[0]; bb[5] = b[1]; bb[6] = b[2]; bb[7] = b[3]; }
#pragma unroll
        for (int i = 0; i < 8; ++i) { float o[8];
#pragma unroll
            for (int j = 0; j < 8; ++j) o[j] = bb[j];
#pragma unroll
            for (int k = 0; k < 4; ++k) { const int rk = i + k;
                float x[8];
                if (rk < 3) {
#pragma unroll
                    for (int j = 0; j < 8; ++j) x[j] = hv[rk][j];
                } else { const u32x4 L = r.L[rk]; x[0] = bflo(L.x); x[1] = bfhi(L.x); x[2] = bflo(L.y); x[3] = bfhi(L.y); x[4] = bflo(L.z); x[5] = bfhi(L.z); x[6] = bflo(L.w); x[7] = bfhi(L.w); }
#pragma unroll
                for (int j = 0; j < 8; ++j) o[j] += x[j] * w[k][j]; }
#pragma unroll
            for (int j = 0; j < 8; ++j) o[j] = siluf_(o[j]);
            u32x4 q; q.x = pk2(o[0], o[1]); q.y = pk2(o[2], o[3]); q.z = pk2(o[4], o[5]); q.w = pk2(o[6], o[7]);
            *(u32x4*)(XACT + (size_t)(r0 + i) * CONVD + cc) = q; }
        float* cst = nullptr;
        if (smp) cst = p.out + O_CS + (size_t)s * 3 * CONVD + cc;
        else if ((run % (TP / 8)) == TP / 8 - 1) cst = p.out + O_CP + (size_t)(run / (TP / 8)) * 3 * CONVD + cc;
        if (cst) {
#pragma unroll
            for (int j = 0; j < 3; ++j) { const u32x4 L = r.L[8 + j];
                *(f32x4*)(cst + j * CONVD) = (f32x4){bflo(L.x), bfhi(L.x), bflo(L.y), bfhi(L.y)}; *(f32x4*)(cst + j * CONVD + 4) = (f32x4){bflo(L.z), bfhi(L.z), bflo(L.w), bfhi(L.w)}; } }
    };
    {
        const int NIT = NRUN * NCG, stride = gridDim.x * 512;
        int item = blockIdx.x * 512 + tid;
        Raw ra, rb;
        if (item < NIT) load_raw(item, ra);
        while (item < NIT) {
            int nxt = item + stride;
            if (nxt < NIT) load_raw(nxt, rb);
            compute(item, ra);
            item = nxt;
            if (item < NIT) { nxt = item + stride; if (nxt < NIT) load_raw(nxt, ra); compute(item, rb); item = nxt; }
        }
    }
    const float* DTR = (const float*)(p.ws + W_DTRAW); float* DT = (float*)(p.ws + W_DT); float* AC = (float*)(p.ws + W_AC);
    { const int wid = tid >> 6, lane = tid & 63;
      for (int it = blockIdx.x * 8 + wid; it < 68 * 32; it += gridDim.x * 8) { const int ch = it >> 5, h = it & 31;
          const size_t r0 = (size_t)ch * 128 + 2 * lane; const int tseq = (ch % 17) * 128 + 2 * lane;
          float d0 = softplusf_(DTR[r0 * 32 + h] + p.dt_bias[h]), d1 = softplusf_(DTR[(r0 + 1) * 32 + h] + p.dt_bias[h]);
          if (tseq < PADR) d0 = 0.f; if (tseq + 1 < PADR) d1 = 0.f;
          const float a = -__expf(p.a_log[h]), v0 = d0 * a, v1 = d1 * a, s = v0 + v1; float incl = s;
#pragma unroll
          for (int o = 1; o < 64; o <<= 1) { const float nb = __shfl_up(incl, o); if (lane >= o) incl += nb; }
          const float excl = incl - s;
          DT[r0 * 32 + h] = d0; DT[(r0 + 1) * 32 + h] = d1; AC[r0 * 32 + h] = excl + v0; AC[(r0 + 1) * 32 + h] = excl + s; } }
    for (int e = ROWS_P * 32 + blockIdx.x * 512 + tid; e < TROWS * 32; e += gridDim.x * 512) DT[e] = softplusf_(DTR[e] + p.dt_bias[e & 31]);
}

typedef short s16x4 __attribute__((ext_vector_type(4)));
constexpr int XROW = 72, LROW = 136;
__device__ __forceinline__ u32x2 tr4(LAS bf16_t* img, int stride, int R0, int col0, int fr) {
    const s16x4 v = __builtin_amdgcn_ds_read_tr16_b64_v4i16((LAS s16x4*)(img + (R0 + (fr >> 2)) * stride + col0 + 4 * (fr & 3)));
    return __builtin_bit_cast(u32x2, v);
}
__device__ __forceinline__ void ssd_prompt(const Params& p, LAS unsigned char* lds, int b, int h) {
    const int tid = tid_opaque(), wid = __builtin_amdgcn_readfirstlane(tid >> 6), lane = tid & 63, fr = lane & 15, fq = lane >> 4;
    const int g = h >> 3;
    LAS bf16_t* sX = (LAS bf16_t*)(lds);
    LAS bf16_t* sB = (LAS bf16_t*)(lds + 18432);
    LAS bf16_t* sC = (LAS bf16_t*)(lds + 53248);
    LAS bf16_t* sH = (LAS bf16_t*)(lds + 88064);
    LAS float* sDt = (LAS float*)(lds + 105472);
    LAS float* sAc = sDt + 128;
    LAS float* sW = sAc + 128;
    const bf16_t* PROJ = (const bf16_t*)(p.ws + W_PROJ);
    const bf16_t* XACT = (const bf16_t*)(p.ws + W_XACT);
    const float* DT = (const float*)(p.ws + W_DT);
    const float* AC = (const float*)(p.ws + W_AC);
    bf16_t* A2 = (bf16_t*)(p.ws + W_A2);
    float* YSS = (float*)(p.ws + W_YSS);
    const float Dh = p.d_skip[h];
    for (int i = tid; i < 64 * LROW / 2; i += 512) ((LAS unsigned*)sH)[i] = 0u;
    f32x4 hacc[4];
#pragma unroll
    for (int i = 0; i < 4; ++i) hacc[i] = (f32x4){0.f, 0.f, 0.f, 0.f};
    const int trow = 16 * wid + fr;
    u32x4 rx[2], rb[4], rc[4]; u32x2 rz[4]; float rd0 = 0.f, rd1 = 0.f, ra0 = 0.f, ra1 = 0.f;
#define SSD_ISSUE(cn) do { const size_t nb_ = (size_t)b * TP + (size_t)(cn) * 128; \
        _Pragma("unroll") for (int i = 0; i < 2; ++i) { const int v_ = tid + 512 * i; rx[i] = __builtin_nontemporal_load((const u32x4*)(XACT + (nb_ + (v_ >> 3)) * CONVD + h * 64 + (v_ & 7) * 8)); } \
        _Pragma("unroll") for (int i = 0; i < 4; ++i) { const int v_ = tid + 512 * i; const bf16_t* q_ = XACT + (nb_ + (v_ >> 4)) * CONVD + 2048 + g * 128 + (v_ & 15) * 8; rb[i] = *(const u32x4*)q_; rc[i] = *(const u32x4*)(q_ + 512); } \
        if (wid == 0) { rd0 = DT[(nb_ + 2 * lane) * 32 + h]; rd1 = DT[(nb_ + 2 * lane + 1) * 32 + h]; ra0 = AC[(nb_ + 2 * lane) * 32 + h]; ra1 = AC[(nb_ + 2 * lane + 1) * 32 + h]; } } while (0)
#define SSD_ISSUE_Z(cn) do { const bf16_t* q_ = PROJ + ((size_t)b * TP + (size_t)(cn) * 128 + trow) * NPROJ + C_Z + h * 64 + 4 * fq; \
        _Pragma("unroll") for (int pt = 0; pt < 4; ++pt) rz[pt] = __builtin_nontemporal_load((const u32x2*)(q_ + 16 * pt)); } while (0)
    SSD_ISSUE(0); SSD_ISSUE_Z(0);
    for (int c = 0; c < 17; ++c) {
        const int base = b * TP + c * 128;
        if (wid == 0) { const int t0 = 2 * lane; sDt[t0] = rd0; sDt[t0 + 1] = rd1; sAc[t0] = ra0; sAc[t0 + 1] = ra1; }
#pragma unroll
        for (int i = 0; i < 2; ++i) { const int v_ = tid + 512 * i; *(LAS u32x4*)(sX + (v_ >> 3) * XROW + (v_ & 7) * 8) = rx[i]; }
#pragma unroll
        for (int i = 0; i < 4; ++i) { const int v_ = tid + 512 * i; *(LAS u32x4*)(sB + (v_ >> 4) * LROW + (v_ & 15) * 8) = rb[i]; *(LAS u32x4*)(sC + (v_ >> 4) * LROW + (v_ & 15) * 8) = rc[i]; }
        __syncthreads();
        const int cn = c < 16 ? c + 1 : 16;
        SSD_ISSUE(cn);
        if (tid < 128) sW[tid] = __expf(sAc[127] - sAc[tid]) * sDt[tid];
        const float act = sAc[trow];
        bf16x8 cf[4];
#pragma unroll
        for (int kk = 0; kk < 4; ++kk) cf[kk] = *(const LAS bf16x8*)(sC + trow * LROW + 32 * kk + 8 * fq);
        f32x4 d[8];
#pragma unroll
        for (int st = 0; st < 8; ++st) d[st] = (f32x4){0.f, 0.f, 0.f, 0.f};
#pragma unroll
        for (int kk = 0; kk < 4; ++kk) {
            bf16x8 bfr[8];
#pragma unroll
            for (int st = 0; st < 8; ++st) bfr[st] = *(const LAS bf16x8*)(sB + (16 * st + fr) * LROW + 32 * kk + 8 * fq);
#pragma unroll
            for (int st = 0; st < 8; ++st) d[st] = __builtin_amdgcn_mfma_f32_16x16x32_bf16(bfr[st], cf[kk], d[st], 0, 0, 0);
        }
        bf16x8 gfrag[4];
        {
#pragma unroll
            for (int kb = 0; kb < 4; ++kb) {
                f32x4 acs[2], dts[2];
#pragma unroll
                for (int hf = 0; hf < 2; ++hf) { acs[hf] = *(const LAS f32x4*)(sAc + 16 * (2 * kb + hf) + 4 * fq); dts[hf] = *(const LAS f32x4*)(sDt + 16 * (2 * kb + hf) + 4 * fq); }
                unsigned pkd[4];
#pragma unroll
                for (int hf = 0; hf < 2; ++hf) { const int st = 2 * kb + hf; float gv[4];
#pragma unroll
                    for (int jj = 0; jj < 4; ++jj) { const int s = 16 * st + 4 * fq + jj; gv[jj] = (s <= trow) ? d[st][jj] * __expf(act - acs[hf][jj]) * dts[hf][jj] : 0.f; }
                    pkd[2 * hf] = pk2(gv[0], gv[1]); pkd[2 * hf + 1] = pk2(gv[2], gv[3]); }
                u32x4 w; w.x = pkd[0]; w.y = pkd[1]; w.z = pkd[2]; w.w = pkd[3];
                gfrag[kb] = __builtin_bit_cast(bf16x8, w);
            }
        }
        const float eact = __expf(act);
        const int grow = base + trow;
        f32x4 y[4];
#pragma unroll
        for (int pt = 0; pt < 4; ++pt) y[pt] = (f32x4){0.f, 0.f, 0.f, 0.f};
#pragma unroll
        for (int kk = 0; kk < 4; ++kk) {
            bf16x8 hf[4];
#pragma unroll
            for (int pt = 0; pt < 4; ++pt) hf[pt] = *(const LAS bf16x8*)(sH + (16 * pt + fr) * LROW + 32 * kk + 8 * fq);
#pragma unroll
            for (int pt = 0; pt < 4; ++pt) y[pt] = __builtin_amdgcn_mfma_f32_16x16x32_bf16(hf[pt], cf[kk], y[pt], 0, 0, 0);
        }
#pragma unroll
        for (int pt = 0; pt < 4; ++pt) y[pt] *= eact;
#pragma unroll
        for (int kb = 0; kb < 4; ++kb) {
            u32x2 x0[4], x1[4];
#pragma unroll
            for (int pt = 0; pt < 4; ++pt) { x0[pt] = tr4(sX, XROW, 32 * kb + 4 * fq, 16 * pt, fr); x1[pt] = tr4(sX, XROW, 32 * kb + 16 + 4 * fq, 16 * pt, fr); }
#pragma unroll
            for (int pt = 0; pt < 4; ++pt) { u32x4 w; w.x = x0[pt].x; w.y = x0[pt].y; w.z = x1[pt].x; w.w = x1[pt].y;
                y[pt] = __builtin_amdgcn_mfma_f32_16x16x32_bf16(__builtin_bit_cast(bf16x8, w), gfrag[kb], y[pt], 0, 0, 0); }
        }
        float ssq = 0.f;
        {
            u32x2 xx[4];
#pragma unroll
            for (int pt = 0; pt < 4; ++pt) xx[pt] = *(const LAS u32x2*)(sX + trow * XROW + 16 * pt + 4 * fq);
#pragma unroll
            for (int pt = 0; pt < 4; ++pt) {
                const int pc = 16 * pt + 4 * fq;
                const float zf[4] = {bflo(rz[pt].x), bfhi(rz[pt].x), bflo(rz[pt].y), bfhi(rz[pt].y)};
                const float xf[4] = {bflo(xx[pt].x), bfhi(xx[pt].x), bflo(xx[pt].y), bfhi(xx[pt].y)};
                float yo[4];
#pragma unroll
                for (int jj = 0; jj < 4; ++jj) { const float v = (y[pt][jj] + Dh * xf[jj]) * siluf_(zf[jj]); yo[jj] = v; ssq += v * v; }
                u32x2 w; w.x = pk2(yo[0], yo[1]); w.y = pk2(yo[2], yo[3]);
                *(u32x2*)(A2 + (size_t)grow * 4096 + h * 64 + pc) = w;
            }
        }
        ssq += __shfl_xor(ssq, 16); ssq += __shfl_xor(ssq, 32);
        if (fq == 0) YSS[(size_t)grow * 32 + h] = ssq;
        SSD_ISSUE_Z(cn);
        __syncthreads();
        {
            const float dec = __expf(sAc[127]);
            const int ptile = wid & 3, nt0 = (wid >> 2) * 4;
#pragma unroll
            for (int i = 0; i < 4; ++i) hacc[i] *= dec;
#pragma unroll
            for (int kk = 0; kk < 4; ++kk) {
                const int sb = 32 * kk + 8 * fq;
                const u32x2 xlo = tr4(sX, XROW, sb, 16 * ptile, fr), xhi = tr4(sX, XROW, sb + 4, 16 * ptile, fr);
                const f32x4 w0 = *(const LAS f32x4*)(sW + sb), w1 = *(const LAS f32x4*)(sW + sb + 4);
                u32x2 blo[4], bhi[4];
#pragma unroll
                for (int i = 0; i < 4; ++i) { blo[i] = tr4(sB, LROW, sb, 16 * (nt0 + i), fr); bhi[i] = tr4(sB, LROW, sb + 4, 16 * (nt0 + i), fr); }
                u32x4 w;
                w.x = pk2(bflo(xlo.x) * w0[0], bfhi(xlo.x) * w0[1]); w.y = pk2(bflo(xlo.y) * w0[2], bfhi(xlo.y) * w0[3]);
                w.z = pk2(bflo(xhi.x) * w1[0], bfhi(xhi.x) * w1[1]); w.w = pk2(bflo(xhi.y) * w1[2], bfhi(xhi.y) * w1[3]);
                const bf16x8 xa = __builtin_bit_cast(bf16x8, w);
#pragma unroll
                for (int i = 0; i < 4; ++i) { u32x4 bw; bw.x = blo[i].x; bw.y = blo[i].y; bw.z = bhi[i].x; bw.w = bhi[i].y;
                    hacc[i] = __builtin_amdgcn_mfma_f32_16x16x32_bf16(xa, __builtin_bit_cast(bf16x8, bw), hacc[i], 0, 0, 0); }
            }
#pragma unroll
            for (int i = 0; i < 4; ++i)
#pragma unroll
                for (int jj = 0; jj < 4; ++jj) sH[(16 * ptile + 4 * fq + jj) * LROW + 16 * (nt0 + i) + fr] = f2bf(hacc[i][jj]);
        }
        __syncthreads();
    }
#undef SSD_ISSUE
#undef SSD_ISSUE_Z
    { const int ptile = wid & 3, nt0 = (wid >> 2) * 4; float* dst = p.out + O_SP + ((size_t)(b * 32 + h) * 64) * 128;
#pragma unroll
        for (int i = 0; i < 4; ++i)
#pragma unroll
            for (int jj = 0; jj < 4; ++jj) dst[(16 * ptile + 4 * fq + jj) * 128 + 16 * (nt0 + i) + fr] = hacc[i][jj]; }
}

__device__ __forceinline__ void ssd_sample(const Params& p, LAS unsigned char* lds, int s, int g) {
    const int tid = tid_opaque(), wid = __builtin_amdgcn_readfirstlane(tid >> 6), lane = tid & 63, fr = lane & 15, fq = lane >> 4;
    LAS bf16_t* sXT = (LAS bf16_t*)(lds);
    LAS bf16_t* sBT = (LAS bf16_t*)(lds + 8192);
    LAS bf16_t* sBn = (LAS bf16_t*)(lds + 10240);
    LAS bf16_t* sCn = (LAS bf16_t*)(lds + 12288);
    LAS float* sCB = (LAS float*)(lds + 14336);
    LAS float* sDt2 = sCB + 64;
    LAS float* sAc2 = sDt2 + 64;
    const bf16_t* PROJ = (const bf16_t*)(p.ws + W_PROJ);
    const bf16_t* XACT = (const bf16_t*)(p.ws + W_XACT);
    const float* DT = (const float*)(p.ws + W_DT);
    bf16_t* A2 = (bf16_t*)(p.ws + W_A2);
    float* YSS = (float*)(p.ws + W_YSS);
    const int rbase = ROWS_P + s * 8;
    const int h = g * 8 + wid;
    const float* hsrc = p.state_ssm + ((size_t)s * 32 + h) * 8192 + (size_t)fr * 128 + 4 * fq;
    float* hdst = p.out + O_SS + ((size_t)s * 32 + h) * 8192 + (size_t)fr * 128 + 4 * fq;
    f32x4 ha[8], hb[8];
#define SMP_LOADH(dst, pt) do { _Pragma("unroll") for (int nt = 0; nt < 8; ++nt) dst[nt] = __builtin_nontemporal_load((const f32x4*)(hsrc + (pt) * 2048 + nt * 16)); } while (0)
    SMP_LOADH(ha, 0);
    float zv[4][4];
#pragma unroll
    for (int jj = 0; jj < 4; ++jj)
#pragma unroll
        for (int pt = 0; pt < 4; ++pt) zv[jj][pt] = bf2f(PROJ[(size_t)(rbase + ((4 * fq + jj) & 7)) * NPROJ + C_Z + h * 64 + 16 * pt + fr]);
    __builtin_amdgcn_sched_barrier(0);
    { const int row = tid >> 6, cgx = tid & 63; const u32x4 L = *(const u32x4*)(XACT + (size_t)(rbase + row) * CONVD + g * 512 + cgx * 8);
        LAS bf16_t* d = sXT + (cgx * 8) * 8 + row;
        d[0] = (bf16_t)(L.x & 0xffffu); d[8] = (bf16_t)(L.x >> 16); d[16] = (bf16_t)(L.y & 0xffffu); d[24] = (bf16_t)(L.y >> 16);
        d[32] = (bf16_t)(L.z & 0xffffu); d[40] = (bf16_t)(L.z >> 16); d[48] = (bf16_t)(L.w & 0xffffu); d[56] = (bf16_t)(L.w >> 16); }
    if (tid < 256) { const int which = tid >> 7, v = tid & 127, row = v >> 4, cg = v & 15;
        const u32x4 L = *(const u32x4*)(XACT + (size_t)(rbase + row) * CONVD + 2048 + which * 512 + g * 128 + cg * 8);
        *(LAS u32x4*)((which ? sCn : sBn) + row * 128 + cg * 8) = L;
        if (which == 0) { LAS bf16_t* d = sBT + (cg * 8) * 8 + row;
            d[0] = (bf16_t)(L.x & 0xffffu); d[8] = (bf16_t)(L.x >> 16); d[16] = (bf16_t)(L.y & 0xffffu); d[24] = (bf16_t)(L.y >> 16);
            d[32] = (bf16_t)(L.z & 0xffffu); d[40] = (bf16_t)(L.z >> 16); d[48] = (bf16_t)(L.w & 0xffffu); d[56] = (bf16_t)(L.w >> 16); } }
    else if (tid < 320) { const int l = tid - 256, hh = l >> 3, t = l & 7, h2 = g * 8 + hh;
        const float dt = DT[(size_t)(rbase + t) * 32 + h2];
        float v = dt * (-__expf(p.a_log[h2]));
#pragma unroll
        for (int o = 1; o < 8; o <<= 1) { const float nb = __shfl_up(v, o, 8); if (t >= o) v += nb; }
        sDt2[l] = dt; sAc2[l] = v; }
    __syncthreads();
    { const int pair = tid >> 3, part = tid & 7, t = pair >> 3, s2 = pair & 7; float d = 0.f;
        const u32x4 c0 = *(const LAS u32x4*)(sCn + t * 128 + 16 * part), c1 = *(const LAS u32x4*)(sCn + t * 128 + 16 * part + 8);
        const u32x4 b0 = *(const LAS u32x4*)(sBn + s2 * 128 + 16 * part), b1 = *(const LAS u32x4*)(sBn + s2 * 128 + 16 * part + 8);
        d += bflo(c0.x) * bflo(b0.x) + bfhi(c0.x) * bfhi(b0.x) + bflo(c0.y) * bflo(b0.y) + bfhi(c0.y) * bfhi(b0.y) + bflo(c0.z) * bflo(b0.z) + bfhi(c0.z) * bfhi(b0.z) + bflo(c0.w) * bflo(b0.w) + bfhi(c0.w) * bfhi(b0.w);
        d += bflo(c1.x) * bflo(b1.x) + bfhi(c1.x) * bfhi(b1.x) + bflo(c1.y) * bflo(b1.y) + bfhi(c1.y) * bfhi(b1.y) + bflo(c1.z) * bflo(b1.z) + bfhi(c1.z) * bfhi(b1.z) + bflo(c1.w) * bflo(b1.w) + bfhi(c1.w) * bfhi(b1.w);
        d += __shfl_xor(d, 1); d += __shfl_xor(d, 2); d += __shfl_xor(d, 4);
        if (part == 0) sCB[pair] = d; }
    __syncthreads();
    const int tl = fr & 7;
    float ac[8], dtv[8];
    { const f32x4 a0 = *(const LAS f32x4*)(sAc2 + wid * 8), a1 = *(const LAS f32x4*)(sAc2 + wid * 8 + 4), d0 = *(const LAS f32x4*)(sDt2 + wid * 8), d1 = *(const LAS f32x4*)(sDt2 + wid * 8 + 4);
#pragma unroll
      for (int t = 0; t < 4; ++t) { ac[t] = a0[t]; ac[4 + t] = a1[t]; dtv[t] = d0[t]; dtv[4 + t] = d1[t]; } }
    const float aT = ac[7], dec = __expf(aT), Dh = p.d_skip[h];
    float wv[8];
#pragma unroll
    for (int s2 = 0; s2 < 8; ++s2) wv[s2] = __expf(aT - ac[s2]) * dtv[s2];
    bf16x8 gfrag;
    { float actl = ac[0];
#pragma unroll
      for (int k = 1; k < 8; ++k) actl = (tl == k) ? ac[k] : actl;
      const f32x4 cb0 = *(const LAS f32x4*)(sCB + tl * 8), cb1 = *(const LAS f32x4*)(sCB + tl * 8 + 4);
      float gv[8];
#pragma unroll
      for (int s2 = 0; s2 < 8; ++s2) { const float cbv = s2 < 4 ? cb0[s2 & 3] : cb1[s2 & 3]; gv[s2] = (s2 <= tl && fq == 0) ? cbv * __expf(fminf(actl - ac[s2], 0.f)) * dtv[s2] : 0.f; }
      u32x4 w; w.x = pk2(gv[0], gv[1]); w.y = pk2(gv[2], gv[3]); w.z = pk2(gv[4], gv[5]); w.w = pk2(gv[6], gv[7]); gfrag = __builtin_bit_cast(bf16x8, w); }
    bf16x8 cfrag[4];
#pragma unroll
    for (int kk = 0; kk < 4; ++kk) { const u32x2 lo = *(const LAS u32x2*)(sCn + tl * 128 + 32 * kk + 4 * fq), hi = *(const LAS u32x2*)(sCn + tl * 128 + 32 * kk + 16 + 4 * fq);
        u32x4 w; w.x = lo.x; w.y = lo.y; w.z = hi.x; w.w = hi.y; cfrag[kk] = __builtin_bit_cast(bf16x8, w); }
    bf16x8 btf[8];
#pragma unroll
    for (int nt = 0; nt < 8; ++nt) { u32x4 w = *(const LAS u32x4*)(sBT + (16 * nt + fr) * 8); if (fq != 0) w = (u32x4){0u, 0u, 0u, 0u}; btf[nt] = __builtin_bit_cast(bf16x8, w); }
    float eact[4];
#pragma unroll
    for (int jj = 0; jj < 4; ++jj) { float a_ = ac[0];
#pragma unroll
        for (int k = 1; k < 8; ++k) a_ = (((4 * fq + jj) & 7) == k) ? ac[k] : a_;
        eact[jj] = __expf(a_); }
    float ssq[4] = {0.f, 0.f, 0.f, 0.f};
    auto ptile = [&](const f32x4 (&hv)[8], int pt) {
        const u32x4 xr = *(const LAS u32x4*)(sXT + (wid * 64 + 16 * pt + fr) * 8);
        const float xf[8] = {bflo(xr.x), bfhi(xr.x), bflo(xr.y), bfhi(xr.y), bflo(xr.z), bfhi(xr.z), bflo(xr.w), bfhi(xr.w)};
        f32x4 y = (f32x4){0.f, 0.f, 0.f, 0.f};
#pragma unroll
        for (int kk = 0; kk < 4; ++kk) { u32x4 w; w.x = pk2(hv[2 * kk][0], hv[2 * kk][1]); w.y = pk2(hv[2 * kk][2], hv[2 * kk][3]); w.z = pk2(hv[2 * kk + 1][0], hv[2 * kk + 1][1]); w.w = pk2(hv[2 * kk + 1][2], hv[2 * kk + 1][3]);
            y = __builtin_amdgcn_mfma_f32_16x16x32_bf16(cfrag[kk], __builtin_bit_cast(bf16x8, w), y, 0, 0, 0); }
#pragma unroll
        for (int jj = 0; jj < 4; ++jj) y[jj] *= eact[jj];
        { u32x4 w = fq == 0 ? xr : (u32x4){0u, 0u, 0u, 0u}; y = __builtin_amdgcn_mfma_f32_16x16x32_bf16(gfrag, __builtin_bit_cast(bf16x8, w), y, 0, 0, 0); }
        if (fq < 2) {
            float xt[4];
#pragma unroll
            for (int jj = 0; jj < 4; ++jj) xt[jj] = fq == 0 ? xf[jj] : xf[4 + jj];
#pragma unroll
            for (int jj = 0; jj < 4; ++jj) { const float v = (y[jj] + Dh * xt[jj]) * siluf_(zv[jj][pt]); ssq[jj] += v * v;
                A2[(size_t)(rbase + 4 * fq + jj) * 4096 + h * 64 + 16 * pt + fr] = f2bf(v); }
        }
        u32x4 xw; xw.x = pk2(xf[0] * wv[0], xf[1] * wv[1]); xw.y = pk2(xf[2] * wv[2], xf[3] * wv[3]); xw.z = pk2(xf[4] * wv[4], xf[5] * wv[5]); xw.w = pk2(xf[6] * wv[6], xf[7] * wv[7]);
        if (fq != 0) xw = (u32x4){0u, 0u, 0u, 0u};
        const bf16x8 xwf = __builtin_bit_cast(bf16x8, xw);
#pragma unroll
        for (int nt = 0; nt < 8; ++nt) { f32x4 acc = hv[nt] * dec; acc = __builtin_amdgcn_mfma_f32_16x16x32_bf16(btf[nt], xwf, acc, 0, 0, 0);
            *(f32x4*)(hdst + pt * 2048 + nt * 16) = acc; }
    };
    SMP_LOADH(hb, 1); __builtin_amdgcn_sched_barrier(0);
    ptile(ha, 0); SMP_LOADH(ha, 2); __builtin_amdgcn_sched_barrier(0);
    ptile(hb, 1); SMP_LOADH(hb, 3); __builtin_amdgcn_sched_barrier(0);
    ptile(ha, 2); __builtin_amdgcn_sched_barrier(0);
    ptile(hb, 3);
#undef SMP_LOADH
#pragma unroll
    for (int jj = 0; jj < 4; ++jj) { float v = ssq[jj]; v += __shfl_xor(v, 1); v += __shfl_xor(v, 2); v += __shfl_xor(v, 4); v += __shfl_xor(v, 8); ssq[jj] = v; }
    if (fr == 0 && fq < 2) {
#pragma unroll
        for (int jj = 0; jj < 4; ++jj) YSS[(size_t)(rbase + 4 * fq + jj) * 32 + h] = ssq[jj]; }
    __syncthreads();
}
__device__ __forceinline__ void phase_elem(const Params& p, unsigned char* smem) {
    phase_conv(p);
    for (int it = blockIdx.x; it < 544 + 512; it += gridDim.x) {
        if (it < 544) pool_prompt(p, smem, it / 136, (it % 136) >> 2, it & 3);
        else { const int j = it - 544; pool_sample(p, j >> 2, j & 3); }
    }
}
__device__ __forceinline__ void phase_ssd(const Params& p, unsigned char* smem) {
    const int G = gridDim.x, bid = blockIdx.x;
    if (bid < 128) {
        const int xcd = bid & 7, slot = bid >> 3, pair = xcd * 2 + (slot >> 3);
        ssd_prompt(p, (LAS unsigned char*)smem, pair >> 2, (pair & 3) * 8 + (slot & 7)); }
    else for (int it = bid - 128; it < 512; it += G - 128) ssd_sample(p, (LAS unsigned char*)smem, it >> 2, it & 3);
}

__device__ __forceinline__ void phase_ynorm(const Params& p, int vbid, int vG) {
    const int tid = tid_opaque(); const int wid = tid >> 6, lane = tid & 63;
    bf16_t* A2 = (bf16_t*)(p.ws + W_A2); const float* YSS = (const float*)(p.ws + W_YSS);
    for (int it = vbid * 8 + wid; it < TROWS * 4; it += vG * 8) {
        const int row = it >> 2, g = it & 3;
        const f32x4 s0 = *(const f32x4*)(YSS + (size_t)row * 32 + g * 8), s1 = *(const f32x4*)(YSS + (size_t)row * 32 + g * 8 + 4);
        const float ss = s0[0] + s0[1] + s0[2] + s0[3] + s1[0] + s1[1] + s1[2] + s1[3];
        const float rs = rsqrtf(ss * (1.0f / 512.0f) + EPS);
        bf16_t* ptr = A2 + (size_t)row * 4096 + g * 512 + lane * 8;
        const u32x4 v = *(const u32x4*)ptr;
        const f32x4 w0 = *(const f32x4*)(p.ssd_norm_w + g * 512 + lane * 8), w1 = *(const f32x4*)(p.ssd_norm_w + g * 512 + lane * 8 + 4);
        u32x4 o; o.x = pk2(bflo(v.x) * rs * w0[0], bfhi(v.x) * rs * w0[1]); o.y = pk2(bflo(v.y) * rs * w0[2], bfhi(v.y) * rs * w0[3]);
        o.z = pk2(bflo(v.z) * rs * w1[0], bfhi(v.z) * rs * w1[1]); o.w = pk2(bflo(v.w) * rs * w1[2], bfhi(v.w) * rs * w1[3]);
        *(u32x4*)ptr = o;
    }
}
__device__ __forceinline__ void phase_final(const Params& p, int rb, int re, int vbid, int vG) {
    const int tid = tid_opaque(); const int wid = tid >> 6, lane = tid & 63;
    const float* RSS = (const float*)(p.ws + W_RSS);
    for (int r = rb + vbid * 8 + wid; r < re; r += vG * 8) {
        float* dst = row_dst(p, r); if (!dst) continue;
        float ss = lane < 32 ? RSS[(size_t)r * 32 + lane] : 0.f;
#pragma unroll
        for (int o = 32; o >= 1; o >>= 1) ss += __shfl_xor(ss, o);
        const float rs = rsqrtf(ss * (1.0f / DM) + EPS);
#pragma unroll
        for (int i = 0; i < 8; ++i) { f32x4 v = __builtin_nontemporal_load((const f32x4*)dst + lane + 64 * i); const f32x4 w = ((const f32x4*)p.final_norm_w)[lane + 64 * i];
            v[0] *= rs * w[0]; v[1] *= rs * w[1]; v[2] *= rs * w[2]; v[3] *= rs * w[3]; ((f32x4*)dst)[lane + 64 * i] = v; }
    }
}


#define XB_TMO      128
#define XB_XCNT(j)  (256  + 64 * (j))
#define XB_XSUB(j)  (1280 + 64 * (j))
#define XB_XGEN(j)  (2304 + 64 * (j))
#define XB_TOP      3328
#define XB_TOPGEN   3392
#define XCD_BAR_WORDS 3456
#define XB_SPIN_CAP (1u << 18)
__device__ __forceinline__ unsigned xb_ld(unsigned* p)              { return __hip_atomic_load(p, __ATOMIC_RELAXED, __HIP_MEMORY_SCOPE_AGENT); }
__device__ __forceinline__ unsigned xb_add(unsigned* p, unsigned v) { return __hip_atomic_fetch_add(p, v, __ATOMIC_RELAXED, __HIP_MEMORY_SCOPE_AGENT); }
__device__ __forceinline__ unsigned xb_xcc_id() { return (unsigned)__builtin_amdgcn_s_getreg((3 << 11) | 20) & 0xFu; }
#define XB_SPIN(cond, bar) do { unsigned _sp = 0; while (cond) { __builtin_amdgcn_s_sleep(1); \
    if ((++_sp & 255u) == 0u) { if (xb_ld(&(bar)[XB_TMO])) break; if (_sp > XB_SPIN_CAP) { atomicAdd(&(bar)[XB_TMO], 1u); break; } } } } while (0)
struct XcdBarrier { unsigned* bar; unsigned x; volatile LAS unsigned* st; };
__device__ __forceinline__ XcdBarrier xcd_barrier_post(unsigned* bar, volatile LAS unsigned* st) {
    XcdBarrier b; b.bar = bar; b.x = xb_xcc_id(); b.st = st;
    if (threadIdx.x == 0) (void)xb_add(&bar[XB_XCNT(b.x)], 1u);
    return b;
}
__device__ __forceinline__ void xcd_barrier_complete(unsigned* bar, unsigned x, unsigned& nloc, unsigned& nx) {
    const unsigned G = gridDim.x * gridDim.y * gridDim.z;
    unsigned sum, cnt, mine, sp = 0u;
    for (;;) {
        sum = 0u; cnt = 0u; mine = 0u;
#pragma unroll
        for (unsigned j = 0; j < 16; ++j) { const unsigned c = xb_ld(&bar[XB_XCNT(j)]); sum += c; cnt += (c > 0u) ? 1u : 0u; mine = (j == x) ? c : mine; }
        if (sum == G) break;
        __builtin_amdgcn_s_sleep(1);
        if ((++sp & 255u) == 0u) { if (xb_ld(&bar[XB_TMO])) break; if (sp > XB_SPIN_CAP) { atomicAdd(&bar[XB_TMO], 1u); break; } }
    }
    nloc = mine > 0u ? mine : 1u; nx = cnt > 0u ? cnt : 1u;
}
__device__ __forceinline__ void xcd_barrier(const XcdBarrier& b) {
    asm volatile("s_waitcnt vmcnt(0)" ::: "memory");
    __syncthreads();
    if (threadIdx.x == 0) {
        unsigned* bar = b.bar;
        __builtin_amdgcn_s_waitcnt(0);
        unsigned nloc = b.st[0], nx = b.st[1];
        if (nloc == 0u) { xcd_barrier_complete(bar, b.x, nloc, nx); b.st[0] = nloc; b.st[1] = nx; }
        const unsigned old = xb_add(&bar[XB_XSUB(b.x)], 1u);
        const unsigned gen = old / nloc;
        if (old + 1u == (gen + 1u) * nloc) {
            __builtin_amdgcn_fence(__ATOMIC_RELEASE, "agent");
            asm volatile("s_waitcnt vmcnt(0)" ::: "memory");
            const unsigned og = xb_add(&bar[XB_TOP], 1u);
            const unsigned tg = og / nx;
            if (og + 1u == (tg + 1u) * nx) xb_add(&bar[XB_TOPGEN], 1u);
            else XB_SPIN(xb_ld(&bar[XB_TOPGEN]) == tg, bar);
            __builtin_amdgcn_fence(__ATOMIC_ACQUIRE, "agent");
            xb_add(&bar[XB_XGEN(b.x)], 1u);
            asm volatile("s_waitcnt vmcnt(0)" ::: "memory");
        } else {
            XB_SPIN(xb_ld(&bar[XB_XGEN(b.x)]) == gen, bar);
            __builtin_amdgcn_fence(__ATOMIC_ACQUIRE, "agent");
            asm volatile("s_waitcnt vmcnt(0)" ::: "memory");
        }
    }
    __syncthreads();
}

__global__ void __launch_bounds__(512, 2) fwd_megakernel(Params p) {
    extern __shared__ __attribute__((aligned(16))) unsigned char shm[];
    cg::grid_group grid = cg::this_grid();
    LAS unsigned char* lds = (LAS unsigned char*)shm;
    bf16_t* XN = (bf16_t*)(p.ws + W_XN); bf16_t* PROJ = (bf16_t*)(p.ws + W_PROJ); bf16_t* A2 = (bf16_t*)(p.ws + W_A2);
    volatile LAS unsigned* xst = (volatile LAS unsigned*)(lds + LDS_BYTES - 16);
    if (threadIdx.x == 0) { xst[0] = 0u; xst[1] = 0u; }
    __syncthreads();
    if (blockIdx.x == 0 && threadIdx.x < 64) {
        unsigned* bw = (unsigned*)(p.ws + W_BAR);
        for (int i = threadIdx.x; i < 4096; i += 64) __hip_atomic_store(bw + i, 0u, __ATOMIC_RELAXED, __HIP_MEMORY_SCOPE_AGENT);
        asm volatile("s_waitcnt vmcnt(0)" ::: "memory");
        __builtin_amdgcn_fence(__ATOMIC_RELEASE, "agent");
        asm volatile("s_waitcnt vmcnt(0)" ::: "memory");
    }
    grid.sync();
    const XcdBarrier xb = xcd_barrier_post((unsigned*)(p.ws + W_BAR), xst);
    phase_prep(p, (float*)shm);
    xcd_barrier(xb);
    { GemmD g{XN, (const bf16_t*)(p.ws + W_WINT), DM, DM, DM, TROWS / BM, NPROJ / BM, 0, 0, 1, 0, (int)blockIdx.x, (int)gridDim.x, 0, (TROWS / BM) * (NPROJ / BM), 0};
      EpiProj e{PROJ, (float*)(p.ws + W_DTRAW)};
      gemm_phase(lds, g, e); }
    xcd_barrier(xb);
    phase_elem(p, shm);
    xcd_barrier(xb);
    phase_ssd(p, shm);
    xcd_barrier(xb);
    { GemmD g{XN  , (const bf16_t*)(p.ws + W_WMIX), DM, 512, 512, TROWS / BM, DM / BM, 2, 512, 1, 0, (int)blockIdx.x, (int)gridDim.x, 0, (TROWS / BM) * (DM / BM), 0};
      EpiMix e{PROJ, A2, p.pool_mix_b, p.pool_scale};
      gemm_phase(lds, g, e); }
    if (blockIdx.x >= 48) phase_ynorm(p, blockIdx.x - 48, gridDim.x - 48);
    xcd_barrier(xb);
#pragma unroll 1
    for (int stage = 0; stage < 3; ++stage) {
        const int bid = blockIdx.x;
        float* Fh = (float*)(p.ws + W_XACT);
        if (stage == 0) {
            GemmD g{A2, (const bf16_t*)(p.ws + W_WSP), 4096, 4096, 2048, 32, DM / BM, 0, 0, 2, 0, bid, 256, 0, 256, 0};
            EpiMerged e{PROJ, XN  };
            gemm_phase(lds, g, e);
        } else if (stage == 1 && bid < 96) {
            const int which = bid >= 48 ? 1 : 0;
            GemmD g{A2 + which * 2048, (const bf16_t*)(p.ws + W_WSP) + which * 2048, 4096, 4096, 2048, 6, DM / BM, 0, 0, 1, 32, bid - 48 * which, 48, 0, 48, 0};
            EpiHalf e{PROJ, Fh + (size_t)which * 1536 * DM, which};
            gemm_phase(lds, g, e);
        } else if (stage == 1 || bid < 144) {
            const bool tailp = (stage == 2 && bid >= 96);
            GemmD g{XN  , (const bf16_t*)(p.ws + W_WOUT), DM, DM, DM, tailp ? 6 : 32, DM / BM, 0, 0, 1, tailp ? 32 : 0,
                    stage == 1 ? bid - 96 : (tailp ? bid - 96 : bid), stage == 1 ? 160 : (tailp ? 48 : 96), (stage == 2 && !tailp) ? 160 : 0, stage == 1 ? 160 : (tailp ? 48 : 256), tailp ? 0 : 1};
            EpiOut e{p, (float*)(p.ws + W_RSS)};
            gemm_phase(lds, g, e);
        } else if (stage == 2) {
            phase_final(p, 0, 5120, bid - 144, 112);
        }
        xcd_barrier(xb);
        if (stage == 1) {
            const int tid = tid_opaque();
            for (int i = bid * 512 + tid; i < 1536 * DM / 8; i += 256 * 512) {
                const f32x4 a0 = __builtin_nontemporal_load((const f32x4*)(Fh + (size_t)i * 8)), a1 = __builtin_nontemporal_load((const f32x4*)(Fh + (size_t)i * 8 + 4)), b0 = __builtin_nontemporal_load((const f32x4*)(Fh + (size_t)1536 * DM + (size_t)i * 8)), b1 = __builtin_nontemporal_load((const f32x4*)(Fh + (size_t)1536 * DM + (size_t)i * 8 + 4));
                u32x4 w; w.x = pk2(a0[0] + b0[0], a0[1] + b0[1]); w.y = pk2(a0[2] + b0[2], a0[3] + b0[3]); w.z = pk2(a1[0] + b1[0], a1[1] + b1[1]); w.w = pk2(a1[2] + b1[2], a1[3] + b1[3]);
                *(u32x4*)(XN + (size_t)8192 * DM + (size_t)i * 8) = w; }
            xcd_barrier(xb);
        }
    }
    phase_final(p, 5120, TROWS, blockIdx.x, gridDim.x);
}

extern "C" void kernel_launch(void* const* d_in, const int* in_sizes, int n_in, void* d_out, int out_size, void* d_ws, size_t ws_size, hipStream_t stream) {
    static int grid_blocks = 0;
    if (!grid_blocks) {
        int dev = 0, cus = 0, per_cu = 0;
        hipGetDevice(&dev);
        hipDeviceGetAttribute(&cus, hipDeviceAttributeMultiprocessorCount, dev);
        hipFuncSetAttribute((const void*)fwd_megakernel, hipFuncAttributeMaxDynamicSharedMemorySize, LDS_BYTES);
        hipOccupancyMaxActiveBlocksPerMultiprocessor(&per_cu, fwd_megakernel, 512, LDS_BYTES);
        if (per_cu > 1) per_cu = 1;
        grid_blocks = cus * per_cu;
        grid_blocks &= ~7;
        if (grid_blocks != 256) { fprintf(stderr, "this kernel's static schedule needs exactly 256 resident workgroups (got %d)\n", grid_blocks); grid_blocks = -1; }
    }
    if (ws_size < W_END || grid_blocks <= 0) { fprintf(stderr, "workspace too small or no occupancy (%zu, %d)\n", ws_size, grid_blocks); return; }
    Params p{};
    const float** f = (const float**)&p;
    for (int i = 0; i < 21; ++i) f[i] = (const float*)d_in[i];
    p.out = (float*)d_out; p.ws = (unsigned char*)d_ws;
    void* args[] = {&p};
    hipError_t e = hipLaunchCooperativeKernel((void*)fwd_megakernel, dim3(grid_blocks), dim3(512), args, LDS_BYTES, stream);
    if (e != hipSuccess) fprintf(stderr, "cooperative launch failed: %s (grid %d)\n", hipGetErrorString(e), grid_blocks);
}
```

```cpp
#include <hip/hip_runtime.h>
#include <hip/hip_cooperative_groups.h>
#include <cstdio>
namespace cg = cooperative_groups;

#define LAS __attribute__((address_space(3)))
typedef unsigned short bf16_t;
typedef short bf16x8 __attribute__((ext_vector_type(8)));
typedef float f32x4 __attribute__((ext_vector_type(4)));
typedef unsigned u32x4 __attribute__((ext_vector_type(4)));
typedef unsigned u32x2 __attribute__((ext_vector_type(2)));

constexpr int DM = 2048;
constexpr int TP = 2176;
constexpr int PADR = 112;
constexpr int ROWS_P = 4 * TP;
constexpr int TROWS = ROWS_P + 1024;
constexpr int NPROJ = 13568;
constexpr int C_Z = 0, C_XBC = 2048, C_ZP = 5120, C_U = 7168, C_GS = 9216, C_GP = 11264, C_DT = 13312;
constexpr int CONVD = 3072;
constexpr float EPS = 1e-6f;
constexpr size_t O_YP = 0, O_YS = 16777216, O_CP = 18874368, O_SP = 18911232, O_PP = 19959808, O_CS = 20082688, O_SS = 21262336, O_PS = 54816768;
constexpr size_t W_XN = 0;
constexpr size_t W_WINT = 39845888;
constexpr size_t W_WSP = W_WINT + 55574528;
constexpr size_t W_WMIX = W_WSP + 16777216;
constexpr size_t W_WOUT = W_WMIX + 2097152;
constexpr size_t W_PROJ = W_WOUT + 8388608;
constexpr size_t W_DTRAW = W_PROJ + 263979008;
constexpr size_t W_A2 = W_DTRAW + 1245184;
constexpr size_t W_YSS = W_A2 + 79691776;
constexpr size_t W_RSS = W_YSS + 1245184;
constexpr size_t W_XACT = W_RSS + 1245184;
constexpr size_t W_AC = W_XACT + 59768832;
constexpr size_t W_BAR = W_AC + 1114112;
constexpr size_t W_DT = W_BAR + 16384;
constexpr size_t W_END = W_DT + 1245184;
constexpr int LDS_BYTES = 147456;

struct Params {
    const float *x_prompt, *x_sample, *state_conv, *state_ssm, *state_pool, *meta, *norm_w, *w_in, *conv_w, *conv_b, *dt_bias, *a_log, *d_skip,
        *ssd_norm_w, *w_proj_ssd, *pool_mix_w, *pool_mix_b, *pool_scale, *w_proj_pool, *w_out, *final_norm_w;
    float* out;
    unsigned char* ws;
};

__device__ __forceinline__ int tid_opaque() { int t = threadIdx.x; asm volatile("" : "+v"(t)); return t; }
__device__ __forceinline__ float bf2f(unsigned b) { return __uint_as_float(b << 16); }
__device__ __forceinline__ float bflo(unsigned w) { return __uint_as_float(w << 16); }
__device__ __forceinline__ float bfhi(unsigned w) { return __uint_as_float(w & 0xffff0000u); }
__device__ __forceinline__ unsigned pk2(float lo, float hi) { unsigned r; asm("v_cvt_pk_bf16_f32 %0, %1, %2" : "=v"(r) : "v"(lo), "v"(hi)); return r; }
__device__ __forceinline__ bf16_t f2bf(float f) { return (bf16_t)(pk2(f, 0.f) & 0xffffu); }
__device__ __forceinline__ float sigmoidf_(float x) { return __builtin_amdgcn_rcpf(1.0f + __expf(-x)); }
__device__ __forceinline__ float siluf_(float x) { return x * __builtin_amdgcn_rcpf(1.0f + __expf(-x)); }
__device__ __forceinline__ float softplusf_(float x) { return x > 20.f ? x : log1pf(__expf(x)); }
__device__ __forceinline__ const float* row_src(const Params& p, int r) {
    if (r < ROWS_P) { const int b = r / TP, t = r - b * TP;
        if (t < PADR) return nullptr;
        if (t < 128) return p.meta + (size_t)(t - PADR) * DM;
        return p.x_prompt + ((size_t)b * 2048 + (t - 128)) * DM; }
    return p.x_sample + (size_t)(r - ROWS_P) * DM;
}
__device__ __forceinline__ float* row_dst(const Params& p, int r) {
    if (r < ROWS_P) { const int b = r / TP, t = r - b * TP;
        if (t < 128) return nullptr;
        return p.out + O_YP + ((size_t)b * 2048 + (t - 128)) * DM; }
    return p.out + O_YS + (size_t)(r - ROWS_P) * DM;
}

constexpr int BM = 256, BK = 64, HALF = 128, HTB = HALF * BK * 2, NXCD = 8, WGM = 8;
__device__ __forceinline__ int lds_byte(int r, int c) { const int st = (r >> 4) * 2 + (c >> 5), rr = r & 15, cc = c & 31, ob = rr * 64 + cc * 2; return st * 1024 + (ob ^ (((ob >> 9) & 1) << 5)); }
__device__ __forceinline__ void stage_rc(int b, int& R, int& C) { const int st = b / 1024, sb = b % 1024, swz = sb ^ (((sb >> 9) & 1) << 5); R = (st >> 1) * 16 + swz / 64; C = (st & 1) * 32 + (swz % 64) / 2; }
__device__ __forceinline__ int perm32(int rho) { const int n = rho >> 4, i = rho & 15; return 8 * (i >> 2) + 4 * n + (i & 3); }
struct Unit { int pm, pn, sub; };
struct GemmD { const bf16_t* A; const bf16_t* Bt; int lda, ldb, K, nM, nN, a_kdiv, a_kstride, nsub, pm_off, vbid, vG, t0, tmax, linear; };
__device__ __forceinline__ bool unit_next(const GemmD& g, int i, Unit& u) {
    u.sub = g.nsub == 2 ? (i & 1) : 0; if (g.nsub == 2) i >>= 1;
    const int nwg = g.nM * g.nN; const long L = (long)g.t0 + (long)i * g.vG + g.vbid; if (L >= g.tmax) return false;
    if (g.linear) { u.pm = g.pm_off + (int)L / g.nN; u.pn = (int)L % g.nN; return true; }
    int wgid = (int)L; { const int q = nwg / NXCD, r = nwg % NXCD, xcd = wgid % NXCD, off = wgid / NXCD; wgid = (xcd < r ? xcd * (q + 1) : r * (q + 1) + (xcd - r) * q) + off; }
    const int nig = WGM * g.nN, gid = wgid / nig, fm = gid * WGM, gsz = (g.nM - fm) < WGM ? (g.nM - fm) : WGM;
    u.pm = g.pm_off + fm + ((wgid % nig) % gsz); u.pn = (wgid % nig) / gsz; return true;
}
__device__ __forceinline__ const char* unit_a(const GemmD& g, const Unit& u) { return (const char*)(g.A + (size_t)u.pm * BM * g.lda + (g.a_kdiv ? (u.pn / g.a_kdiv) * g.a_kstride : 0) + u.sub * g.K); }
__device__ __forceinline__ const char* unit_b(const GemmD& g, const Unit& u) { return (const char*)(g.Bt + (size_t)u.pn * BM * g.ldb + u.sub * g.K); }

template <class Epi>
__device__ __forceinline__ void gemm_phase(LAS unsigned char* lds, const GemmD g, const Epi& E) {
    const int tid = tid_opaque(), wid = __builtin_amdgcn_readfirstlane(tid >> 6), lane = tid & 63, wr = wid >> 2, wc = wid & 3, fr = lane & 15, fq = lane >> 4;
    const int K = g.K, nt = K / BK;
    unsigned voffA[2], voffB[2];
#pragma unroll
    for (int i = 0; i < 2; ++i) { int R, C; stage_rc(tid * 16 + i * 8192, R, C); const int Rb = (R & ~31) + perm32(R & 31);
        voffA[i] = (unsigned)(R * g.lda + C) * 2u; voffB[i] = (unsigned)(Rb * g.ldb + C) * 2u; }
    const size_t kstep = (size_t)(BK * 2);
    const size_t hstepA = (size_t)HALF * g.lda * 2, hstepB = (size_t)HALF * g.ldb * 2;
    const unsigned ldsw = (unsigned)wid * 1024u;
    const int aoff = lds_byte(wr * 64 + fr, fq * 8), boff = lds_byte(wc * 32 + fr, fq * 8);
#define PG8_SA(b, h) (((b) * 2 + (h)) * HTB)
#define PG8_SB(b, h) ((4 + (b) * 2 + (h)) * HTB)
#define PG8_STAGE(bufoff, gbase, voff) do { _Pragma("unroll") for (int _i = 0; _i < 2; ++_i) \
        __builtin_amdgcn_global_load_lds((const unsigned*)((const char*)(gbase) + (voff)[_i]), (LAS unsigned*)(lds + (bufoff) + ldsw + _i * 8192), 16, 0, 0); } while (0)
#define PG8_LDA(dst, b, h) do { _Pragma("unroll") for (int m = 0; m < 4; ++m) _Pragma("unroll") for (int k = 0; k < 2; ++k) dst[m][k] = *(const LAS bf16x8*)(lds + PG8_SA(b, h) + aoff + m * 2048 + k * 1024); } while (0)
#define PG8_LDB(dst, b, h) do { _Pragma("unroll") for (int n = 0; n < 2; ++n) _Pragma("unroll") for (int k = 0; k < 2; ++k) dst[n][k] = *(const LAS bf16x8*)(lds + PG8_SB(b, h) + boff + n * 2048 + k * 1024); } while (0)
#define PG8_MMA(ai, bj, At, Bt) do { __builtin_amdgcn_s_setprio(1); _Pragma("unroll") for (int m = 0; m < 4; ++m) _Pragma("unroll") for (int n = 0; n < 2; ++n) _Pragma("unroll") for (int k = 0; k < 2; ++k) \
        acc[ai][bj][m][n] = __builtin_amdgcn_mfma_f32_16x16x32_bf16(Bt[n][k], At[m][k], acc[ai][bj][m][n], 0, 0, 0); __builtin_amdgcn_s_setprio(0); } while (0)
#define PG8_WAIT_V(n) asm volatile("s_waitcnt vmcnt(" #n ")" ::: "memory")
#define PG8_WAIT_L(n) asm volatile("s_waitcnt lgkmcnt(" #n ")" ::: "memory")
#define PG8_BAR __builtin_amdgcn_s_barrier()
#define PG8_SCHED __builtin_amdgcn_sched_barrier(0)
    Unit cur, nxt; int ui = 0;
    if (!unit_next(g, 0, cur)) return;
    f32x4 acc[2][2][4][2];
#pragma unroll
    for (int a = 0; a < 2; ++a)
#pragma unroll
        for (int b = 0; b < 2; ++b)
#pragma unroll
            for (int m = 0; m < 4; ++m)
#pragma unroll
                for (int n = 0; n < 2; ++n) acc[a][b][m][n] = (f32x4){0.f, 0.f, 0.f, 0.f};
    bf16x8 At[4][2], B0[2][2], B1[2][2];
    const char* cA = unit_a(g, cur); const char* cB = unit_b(g, cur);
    PG8_STAGE(PG8_SB(0, 0), cB, voffB); PG8_STAGE(PG8_SA(0, 0), cA, voffA); PG8_STAGE(PG8_SB(0, 1), cB + hstepB, voffB); PG8_STAGE(PG8_SA(0, 1), cA + hstepA, voffA);
    if (wr == 1) PG8_BAR;
    PG8_WAIT_V(4); PG8_BAR;
    PG8_STAGE(PG8_SB(1, 0), cB + kstep, voffB); PG8_STAGE(PG8_SA(1, 0), cA + kstep, voffA); PG8_STAGE(PG8_SB(1, 1), cB + hstepB + kstep, voffB);
    PG8_WAIT_V(6); PG8_BAR;
    for (;;) {
        const bool has_next = unit_next(g, ui + 1, nxt);
        const char* nA = has_next ? unit_a(g, nxt) : cA; const char* nB = has_next ? unit_b(g, nxt) : cB;
#define PG8_KITER(t) do { \
            const bool last = ((t) == nt - 2); \
            const char* a1 = cA + (size_t)((t) + 1) * kstep; \
            const char* a2 = last ? nA : cA + (size_t)((t) + 2) * kstep; const char* b2 = last ? nB : cB + (size_t)((t) + 2) * kstep; \
            const char* a3 = a2 + kstep; const char* b3 = b2 + kstep; \
            PG8_LDB(B0, 0, 0); PG8_SCHED; PG8_LDA(At, 0, 0); PG8_STAGE(PG8_SA(1, 1), a1 + hstepA, voffA); \
            PG8_WAIT_L(8); PG8_BAR; PG8_WAIT_L(0); PG8_MMA(0, 0, At, B0); PG8_BAR; PG8_SCHED; \
            PG8_LDB(B1, 0, 1); PG8_STAGE(PG8_SB(0, 0), b2, voffB); \
            PG8_BAR; PG8_WAIT_L(0); PG8_MMA(0, 1, At, B1); PG8_BAR; \
            PG8_LDA(At, 0, 1); PG8_STAGE(PG8_SA(0, 0), a2, voffA); \
            PG8_BAR; PG8_WAIT_L(0); PG8_MMA(1, 0, At, B0); PG8_BAR; PG8_SCHED; \
            PG8_STAGE(PG8_SB(0, 1), b2 + hstepB, voffB); \
            PG8_WAIT_V(6); PG8_BAR; PG8_MMA(1, 1, At, B1); PG8_BAR; \
            PG8_LDB(B0, 1, 0); PG8_SCHED; PG8_LDA(At, 1, 0); PG8_STAGE(PG8_SA(0, 1), a2 + hstepA, voffA); \
            PG8_WAIT_L(8); PG8_BAR; PG8_WAIT_L(0); PG8_MMA(0, 0, At, B0); PG8_BAR; PG8_SCHED; \
            PG8_LDB(B1, 1, 1); PG8_STAGE(PG8_SB(1, 0), b3, voffB); \
            PG8_BAR; PG8_WAIT_L(0); PG8_MMA(0, 1, At, B1); PG8_BAR; \
            PG8_LDA(At, 1, 1); PG8_STAGE(PG8_SA(1, 0), a3, voffA); \
            PG8_BAR; PG8_WAIT_L(0); PG8_MMA(1, 0, At, B0); PG8_BAR; PG8_SCHED; \
            PG8_STAGE(PG8_SB(1, 1), b3 + hstepB, voffB); \
            PG8_WAIT_V(6); PG8_BAR; PG8_MMA(1, 1, At, B1); PG8_BAR; } while (0)
        for (int t = 0; t < nt; t += 2) PG8_KITER(t);
#undef PG8_KITER
        bool keep = false;
        if constexpr (Epi::MID) { if (cur.sub == 0) { E.mid(acc, cur, wr, wc, fr, fq); keep = true; } else E(acc, cur, wr, wc, fr, fq); }
        else E(acc, cur, wr, wc, fr, fq);
        if (!has_next) break;
        cur = nxt; cA = nA; cB = nB; ++ui;
        if (keep) continue;
#pragma unroll
        for (int a = 0; a < 2; ++a)
#pragma unroll
            for (int b = 0; b < 2; ++b)
#pragma unroll
                for (int m = 0; m < 4; ++m)
#pragma unroll
                    for (int n = 0; n < 2; ++n) acc[a][b][m][n] = (f32x4){0.f, 0.f, 0.f, 0.f};
    }
    PG8_WAIT_V(0);
    if (wr == 0) PG8_BAR;
    PG8_BAR;
#undef PG8_SA
#undef PG8_SB
#undef PG8_STAGE
#undef PG8_LDA
#undef PG8_LDB
#undef PG8_MMA
#undef PG8_WAIT_V
#undef PG8_WAIT_L
#undef PG8_BAR
#undef PG8_SCHED
}

struct EpiProj {
    static constexpr bool MID = false;
    bf16_t* proj; float* dtraw;
    __device__ __forceinline__ void mid(f32x4 (&)[2][2][4][2], const Unit&, int, int, int, int) const {}
    __device__ __forceinline__ void operator()(const f32x4 (&acc)[2][2][4][2], const Unit& u, int wr, int wc, int fr, int fq) const {
        const int row0 = u.pm * BM + wr * 64 + fr, col0 = u.pn * BM + wc * 32 + 8 * fq;
        const bool sig = (u.pn >= 36 && u.pn < 52), isdt = (u.pn == 52);
#pragma unroll
        for (int ai = 0; ai < 2; ++ai)
#pragma unroll
            for (int m = 0; m < 4; ++m) { const int row = row0 + ai * HALF + m * 16;
#pragma unroll
                for (int bj = 0; bj < 2; ++bj) { const f32x4 v0 = acc[ai][bj][m][0], v1 = acc[ai][bj][m][1]; const int col = col0 + bj * HALF;
                    if (sig) {
                        const int c = (col - C_GS) >> 1;
                        float ra[4], gp[4];
#pragma unroll
                        for (int j = 0; j < 4; ++j) { const float ea = __expf(-fminf(fmaxf(v0[j], -30.f), 30.f)), eb = __expf(-fminf(fmaxf(v1[j], -30.f), 30.f)); gp[j] = __builtin_amdgcn_rcpf(1.0f + eb); ra[j] = (1.0f + eb) * __builtin_amdgcn_rcpf(1.0f + ea); }
                        u32x2 wr_, wg; wr_.x = pk2(ra[0], ra[1]); wr_.y = pk2(ra[2], ra[3]); wg.x = pk2(gp[0], gp[1]); wg.y = pk2(gp[2], gp[3]);
                        *(u32x2*)(proj + (size_t)row * NPROJ + C_GS + c) = wr_;
                        *(u32x2*)(proj + (size_t)row * NPROJ + C_GP + c) = wg;
                    } else {
                        u32x4 w; w.x = pk2(v0[0], v0[1]); w.y = pk2(v0[2], v0[3]); w.z = pk2(v1[0], v1[1]); w.w = pk2(v1[2], v1[3]);
                        *(u32x4*)(proj + (size_t)row * NPROJ + col) = w;
                        if (isdt && col < C_DT + 32) { float* d = dtraw + (size_t)row * 32 + (col - C_DT); *(f32x4*)d = v0; *(f32x4*)(d + 4) = v1; } } } }
    }
};
struct EpiMix {
    static constexpr bool MID = false;
    const bf16_t* proj; bf16_t* a2; const float* bias; const float* scale;
    __device__ __forceinline__ void mid(f32x4 (&)[2][2][4][2], const Unit&, int, int, int, int) const {}
    __device__ __forceinline__ void operator()(const f32x4 (&acc)[2][2][4][2], const Unit& u, int wr, int wc, int fr, int fq) const {
        const int row0 = u.pm * BM + wr * 64 + fr, col0 = u.pn * BM + wc * 32 + 8 * fq;
#pragma unroll
        for (int bj = 0; bj < 2; ++bj) { const int col = col0 + bj * HALF;
            const f32x4 b0 = *(const f32x4*)(bias + col), b1 = *(const f32x4*)(bias + col + 4), s0 = *(const f32x4*)(scale + col), s1 = *(const f32x4*)(scale + col + 4);
#pragma unroll
            for (int ai = 0; ai < 2; ++ai)
#pragma unroll
                for (int m = 0; m < 4; ++m) { const int row = row0 + ai * HALF + m * 16;
                    const u32x4 z = __builtin_nontemporal_load((const u32x4*)(proj + (size_t)row * NPROJ + C_ZP + col));
                    f32x4 v0 = (acc[ai][bj][m][0] + b0) * s0, v1 = (acc[ai][bj][m][1] + b1) * s1;
                    v0[0] *= siluf_(bflo(z.x)); v0[1] *= siluf_(bfhi(z.x)); v0[2] *= siluf_(bflo(z.y)); v0[3] *= siluf_(bfhi(z.y));
                    v1[0] *= siluf_(bflo(z.z)); v1[1] *= siluf_(bfhi(z.z)); v1[2] *= siluf_(bflo(z.w)); v1[3] *= siluf_(bfhi(z.w));
                    u32x4 w; w.x = pk2(v0[0], v0[1]); w.y = pk2(v0[2], v0[3]); w.z = pk2(v1[0], v1[1]); w.w = pk2(v1[2], v1[3]);
                    *(u32x4*)(a2 + (size_t)row * 4096 + 2048 + col) = w; } }
    }
};
struct EpiMerged {
    static constexpr bool MID = true;
    const bf16_t* proj; bf16_t* merged;
    __device__ __forceinline__ void mid(f32x4 (&acc)[2][2][4][2], const Unit& u, int wr, int wc, int fr, int fq) const {
        const int row0 = u.pm * BM + wr * 64 + fr, col0 = u.pn * BM + wc * 32 + 8 * fq;
        u32x4 rv[2][4][2];
#pragma unroll
        for (int ai = 0; ai < 2; ++ai)
#pragma unroll
            for (int m = 0; m < 4; ++m) { const bf16_t* rp = proj + (size_t)(row0 + ai * HALF + m * 16) * NPROJ + C_GS + col0; rv[ai][m][0] = __builtin_nontemporal_load((const u32x4*)(rp)); rv[ai][m][1] = __builtin_nontemporal_load((const u32x4*)(rp + HALF)); }
#pragma unroll
        for (int ai = 0; ai < 2; ++ai)
#pragma unroll
            for (int m = 0; m < 4; ++m)
#pragma unroll
                for (int bj = 0; bj < 2; ++bj) { const u32x4 r = rv[ai][m][bj];
                    acc[ai][bj][m][0] *= (f32x4){bflo(r.x), bfhi(r.x), bflo(r.y), bfhi(r.y)}; acc[ai][bj][m][1] *= (f32x4){bflo(r.z), bfhi(r.z), bflo(r.w), bfhi(r.w)}; }
    }
    __device__ __forceinline__ void operator()(const f32x4 (&acc)[2][2][4][2], const Unit& u, int wr, int wc, int fr, int fq) const {
        const int row0 = u.pm * BM + wr * 64 + fr, col0 = u.pn * BM + wc * 32 + 8 * fq;
#pragma unroll
        for (int ai = 0; ai < 2; ++ai)
#pragma unroll
            for (int m = 0; m < 4; ++m) { const int row = row0 + ai * HALF + m * 16;
#pragma unroll
                for (int bj = 0; bj < 2; ++bj) { const int col = col0 + bj * HALF;
                    const u32x4 gp = __builtin_nontemporal_load((const u32x4*)(proj + (size_t)row * NPROJ + C_GP + col));
                    const f32x4 v0 = acc[ai][bj][m][0], v1 = acc[ai][bj][m][1];
                    u32x4 w; w.x = pk2(v0[0] * bflo(gp.x), v0[1] * bfhi(gp.x)); w.y = pk2(v0[2] * bflo(gp.y), v0[3] * bfhi(gp.y));
                    w.z = pk2(v1[0] * bflo(gp.z), v1[1] * bfhi(gp.z)); w.w = pk2(v1[2] * bflo(gp.w), v1[3] * bfhi(gp.w));
                    *(u32x4*)(merged + (size_t)row * DM + col) = w; } }
    }
};
struct EpiHalf {
    static constexpr bool MID = false;
    const bf16_t* proj; float* F; int which;
    __device__ __forceinline__ void mid(f32x4 (&)[2][2][4][2], const Unit&, int, int, int, int) const {}
    __device__ __forceinline__ void operator()(const f32x4 (&acc)[2][2][4][2], const Unit& u, int wr, int wc, int fr, int fq) const {
        const int row0 = u.pm * BM + wr * 64 + fr, col0 = u.pn * BM + wc * 32 + 8 * fq;
#pragma unroll
        for (int ai = 0; ai < 2; ++ai)
#pragma unroll
            for (int m = 0; m < 4; ++m) { const int row = row0 + ai * HALF + m * 16;
#pragma unroll
                for (int bj = 0; bj < 2; ++bj) { const int col = col0 + bj * HALF;
                    const u32x4 gp = __builtin_nontemporal_load((const u32x4*)(proj + (size_t)row * NPROJ + C_GP + col));
                    f32x4 f0 = (f32x4){bflo(gp.x), bfhi(gp.x), bflo(gp.y), bfhi(gp.y)}, f1 = (f32x4){bflo(gp.z), bfhi(gp.z), bflo(gp.w), bfhi(gp.w)};
                    if (which == 0) { const u32x4 r = *(const u32x4*)(proj + (size_t)row * NPROJ + C_GS + col);
                        f0 *= (f32x4){bflo(r.x), bfhi(r.x), bflo(r.y), bfhi(r.y)}; f1 *= (f32x4){bflo(r.z), bfhi(r.z), bflo(r.w), bfhi(r.w)}; }
                    float* d = F + (size_t)(row - 8192) * DM + col;
                    *(f32x4*)d = acc[ai][bj][m][0] * f0; *(f32x4*)(d + 4) = acc[ai][bj][m][1] * f1; } }
    }
};
struct EpiOut {
    static constexpr bool MID = false;
    Params p; float* rss;
    __device__ __forceinline__ void mid(f32x4 (&)[2][2][4][2], const Unit&, int, int, int, int) const {}
    __device__ __forceinline__ void operator()(const f32x4 (&acc)[2][2][4][2], const Unit& u, int wr, int wc, int fr, int fq) const {
        const int row0 = u.pm * BM + wr * 64 + fr, col0 = u.pn * BM + wc * 32 + 8 * fq;
#pragma unroll
        for (int ai = 0; ai < 2; ++ai)
#pragma unroll
            for (int m = 0; m < 4; ++m) { const int row = row0 + ai * HALF + m * 16;
                const float* src = row_src(p, row); float* dst = row_dst(p, row); float ss = 0.f;
                if (dst) {
#pragma unroll
                    for (int bj = 0; bj < 2; ++bj) { const int col = col0 + bj * HALF;
                        const f32x4 h0 = __builtin_nontemporal_load((const f32x4*)(src + col)), h1 = __builtin_nontemporal_load((const f32x4*)(src + col + 4));
                        const f32x4 v0 = acc[ai][bj][m][0] + h0, v1 = acc[ai][bj][m][1] + h1;
                        *(f32x4*)(dst + col) = v0; *(f32x4*)(dst + col + 4) = v1;
                        ss += v0[0] * v0[0] + v0[1] * v0[1] + v0[2] * v0[2] + v0[3] * v0[3] + v1[0] * v1[0] + v1[1] * v1[1] + v1[2] * v1[2] + v1[3] * v1[3]; } }
                ss += __shfl_xor(ss, 16); ss += __shfl_xor(ss, 32);
                if (fq == 0) rss[(size_t)row * 32 + u.pn * 4 + wc] = ss; }
    }
};

__device__ __forceinline__ int win_src_col(int n) {
    if (n < 5120) return n;
    if (n < C_GS) return n + 32;
    if (n < C_DT) { const int j = n - C_GS, k = j >> 3, wi = j & 7; return ((wi >> 2) ? 11296 : 9248) + 4 * k + (wi & 3); }
    if (n < C_DT + 32) return n - C_DT + 5120;
    return -1;
}
constexpr int TT_LD = 257;
struct TTile { const float* src; bf16_t* dst; int sld, dld, k0, n0, remap; };
__device__ __forceinline__ TTile tt_get(const Params& p, int it) {
    bf16_t* WINT = (bf16_t*)(p.ws + W_WINT); bf16_t* WSP = (bf16_t*)(p.ws + W_WSP); bf16_t* WMIX = (bf16_t*)(p.ws + W_WMIX); bf16_t* WOUT = (bf16_t*)(p.ws + W_WOUT);
    constexpr int NT_IN = 53 * 32, NT_SQ = 8 * 32;
    TTile t;
    if (it < NT_IN) { t = TTile{p.w_in, WINT, 13344, DM, (it & 31) * 64, (it >> 5) * 256, 1}; }
    else if (it < NT_IN + NT_SQ) { const int j = it - NT_IN; t = TTile{p.w_proj_ssd, WSP, DM, 4096, (j & 31) * 64, (j >> 5) * 256, 0}; }
    else if (it < NT_IN + 2 * NT_SQ) { const int j = it - NT_IN - NT_SQ; t = TTile{p.w_proj_pool, WSP + 2048, DM, 4096, (j & 31) * 64, (j >> 5) * 256, 0}; }
    else if (it < NT_IN + 3 * NT_SQ) { const int j = it - NT_IN - 2 * NT_SQ; t = TTile{p.w_out, WOUT, DM, DM, (j & 31) * 64, (j >> 5) * 256, 0}; }
    else { const int j = it - NT_IN - 3 * NT_SQ, gq = j >> 4, r = j & 15; t = TTile{p.pool_mix_w + (size_t)gq * 512 * 512, WMIX + (size_t)gq * 512 * 512, 512, 512, (r & 7) * 64, (r >> 3) * 256, 0}; }
    return t;
}
constexpr int TT_TOTAL = 53 * 32 + 3 * 8 * 32 + 64;
__device__ __forceinline__ void tt_load(const TTile& t, int tid, f32x4 (&v)[8]) {
    const int c4 = tid & 63, kb = tid >> 6; const int n = t.n0 + 4 * c4; const int sc = t.remap ? win_src_col(n) : n;
#pragma unroll
    for (int ps = 0; ps < 8; ++ps) { const int k = ps * 8 + kb; v[ps] = sc >= 0 ? __builtin_nontemporal_load((const f32x4*)(t.src + (size_t)(t.k0 + k) * t.sld + sc)) : (f32x4){0.f, 0.f, 0.f, 0.f}; }
}
__device__ __forceinline__ void phase_prep(const Params& p, float* tile) {
    const int tid = tid_opaque(), wid = tid >> 6, lane = tid & 63;
    bf16_t* XN = (bf16_t*)(p.ws + W_XN);
    for (int r = blockIdx.x * 8 + wid; r < TROWS; r += gridDim.x * 8) {
        const float* src = row_src(p, r); bf16_t* dst = XN + (size_t)r * DM;
        if (!src) {
#pragma unroll
            for (int i = 0; i < 4; ++i) *(u32x4*)(dst + (lane + 64 * i) * 8) = (u32x4){0u, 0u, 0u, 0u};
        } else {
            f32x4 v[8]; float ss = 0.f;
#pragma unroll
            for (int i = 0; i < 8; ++i) { v[i] = __builtin_nontemporal_load((const f32x4*)src + lane + 64 * i); ss += v[i][0] * v[i][0] + v[i][1] * v[i][1] + v[i][2] * v[i][2] + v[i][3] * v[i][3]; }
#pragma unroll
            for (int o = 32; o >= 1; o >>= 1) ss += __shfl_xor(ss, o);
            const float rs = rsqrtf(ss * (1.0f / DM) + EPS);
#pragma unroll
            for (int i = 0; i < 8; ++i) { const f32x4 w = ((const f32x4*)p.norm_w)[lane + 64 * i];
                u32x2 o; o.x = pk2(v[i][0] * rs * w[0], v[i][1] * rs * w[1]); o.y = pk2(v[i][2] * rs * w[2], v[i][3] * rs * w[3]);
                *(u32x2*)(dst + (lane + 64 * i) * 4) = o; }
        }
    }
    int it = blockIdx.x;
    if (it < TT_TOTAL) {
        TTile cur = tt_get(p, it); f32x4 v[8]; tt_load(cur, tid, v);
        for (;;) {
            { const int c4 = tid & 63, kb = tid >> 6;
#pragma unroll
                for (int ps = 0; ps < 8; ++ps) { float* d = tile + (ps * 8 + kb) * TT_LD + 4 * c4; d[0] = v[ps][0]; d[1] = v[ps][1]; d[2] = v[ps][2]; d[3] = v[ps][3]; } }
            __syncthreads();
            const int nit = it + gridDim.x; const bool more = nit < TT_TOTAL;
            const TTile nxt = tt_get(p, more ? nit : it);
            if (more) tt_load(nxt, tid, v);
            { const int kg = tid & 7, nb = tid >> 3;
#pragma unroll
                for (int i = 0; i < 4; ++i) { const int n = nb + 64 * i; float x[8];
#pragma unroll
                    for (int j = 0; j < 8; ++j) x[j] = tile[(kg * 8 + j) * TT_LD + n];
                    u32x4 w; w.x = pk2(x[0], x[1]); w.y = pk2(x[2], x[3]); w.z = pk2(x[4], x[5]); w.w = pk2(x[6], x[7]);
                    *(u32x4*)(cur.dst + (size_t)(cur.n0 + n) * cur.dld + cur.k0 + kg * 8) = w; } }
            __syncthreads();
            if (!more) break;
            cur = nxt; it = nit;
        }
    }
}

__device__ __forceinline__ void pool_prompt(const Params& p, unsigned char* smem, int b, int rt, int g) {
    const int tid = tid_opaque();
    bf16_t* tile = (bf16_t*)smem;
    const bf16_t* PROJ = (const bf16_t*)(p.ws + W_PROJ);
    bf16_t* POOLED = (bf16_t*)(p.ws + W_XN);
    const int r0 = b * TP + rt * 64;
#pragma unroll
    for (int v = tid; v < 79 * 64; v += 512) { const int k = v >> 6, cv = v & 63; int rr = r0 - 15 + k; rr = rr < 0 ? 0 : rr;
        *(u32x4*)(tile + k * 512 + cv * 8) = __builtin_nontemporal_load((const u32x4*)(PROJ + (size_t)rr * NPROJ + C_U + g * 512 + cv * 8)); }
    __syncthreads();
    const int w = 2 << g, c2 = tid & 255, hf = tid >> 8;
    const unsigned* tile32 = (const unsigned*)tile;
    float s0 = 0.f, s1 = 0.f;
    for (int k = 1; k < w; ++k) { const unsigned x = tile32[(15 + 32 * hf - k) * 256 + c2]; s0 += bflo(x); s1 += bfhi(x); }
#pragma unroll 8
    for (int i = 0; i < 32; ++i) {
        const int ri = 32 * hf + i, tseq = rt * 64 + ri; int cnt = tseq - PADR + 1; cnt = cnt > w ? w : cnt; cnt = cnt < 1 ? 1 : cnt;
        const unsigned cu = tile32[(15 + ri) * 256 + c2]; const float c0 = bflo(cu), c1 = bfhi(cu);
        s0 += c0; s1 += c1;
        const float inv = __builtin_amdgcn_rcpf((float)cnt);
        *(unsigned*)(POOLED + (size_t)(r0 + ri) * DM + g * 512 + 2 * c2) = pk2(s0 * inv - c0, s1 * inv - c1);
        const unsigned ou = tile32[(15 + ri - (w - 1)) * 256 + c2]; s0 -= bflo(ou); s1 -= bfhi(ou);
        if (tseq >= TP - 15) { float* d = p.out + O_PP + ((size_t)b * 15 + (tseq - (TP - 15))) * DM + g * 512 + 2 * c2; d[0] = c0; d[1] = c1; }
    }
    __syncthreads();
}
__device__ __forceinline__ void pool_sample(const Params& p, int s, int g) {
    const int col = g * 512 + tid_opaque(), w = 2 << g;
    const bf16_t* PROJ = (const bf16_t*)(p.ws + W_PROJ);
    bf16_t* POOLED = (bf16_t*)(p.ws + W_XN);
    float v[23];
#pragma unroll
    for (int j = 0; j < 15; ++j) v[j] = p.state_pool[((size_t)s * 15 + j) * DM + col];
#pragma unroll
    for (int t = 0; t < 8; ++t) v[15 + t] = bf2f(PROJ[(size_t)(ROWS_P + s * 8 + t) * NPROJ + C_U + col]);
    const float inv = 1.0f / (float)w;
#pragma unroll
    for (int t = 0; t < 8; ++t) { float sum = 0.f;
#pragma unroll
        for (int k = 0; k < 16; ++k) sum += (k < w) ? v[15 + t - k] : 0.f;
        POOLED[(size_t)(ROWS_P + s * 8 + t) * DM + col] = f2bf(sum * inv - v[15 + t]); }
#pragma unroll
    for (int j = 0; j < 15; ++j) p.out[O_PS + ((size_t)s * 15 + j) * DM + col] = v[j + 8];
}

__device__ __forceinline__ void phase_conv(const Params& p) {
    const bf16_t* PROJ = (const bf16_t*)(p.ws + W_PROJ);
    bf16_t* XACT = (bf16_t*)(p.ws + W_XACT);
    constexpr int NRUN = TROWS / 8, NCG = CONVD / 8, NRUN_P = ROWS_P / 8;
    const int tid = tid_opaque();
    struct Raw { u32x4 L[11]; };
    auto load_raw = [&](int item, Raw& r) {
        const int run = item / NCG, cc = (item - run * NCG) * 8, r0 = run * 8;
        const bool smp = run >= NRUN_P;
#pragma unroll
        for (int k = 0; k < 11; ++k) { int rr = r0 - 3 + k; rr = (rr < 0 || (smp && k < 3)) ? r0 : rr; r.L[k] = __builtin_nontemporal_load((const u32x4*)(PROJ + (size_t)rr * NPROJ + C_XBC + cc)); }
    };
    auto compute = [&](int item, const Raw& r) {
        const int run = item / NCG, cc = (item - run * NCG) * 8, r0 = run * 8;
        const bool smp = run >= NRUN_P; const int s = run - NRUN_P;
        const bool zero0 = (!smp && r0 < 3);
        float hv[3][8];
#pragma unroll
        for (int k = 0; k < 3; ++k) {
            if (smp) { const f32x4 a = *(const f32x4*)(p.state_conv + ((size_t)s * 3 + k) * CONVD + cc), b = *(const f32x4*)(p.state_conv + ((size_t)s * 3 + k) * CONVD + cc + 4);
                hv[k][0] = a[0]; hv[k][1] = a[1]; hv[k][2] = a[2]; hv[k][3] = a[3]; hv[k][4] = b[0]; hv[k][5] = b[1]; hv[k][6] = b[2]; hv[k][7] = b[3]; }
            else { const u32x4 L = r.L[k];
                hv[k][0] = bflo(L.x); hv[k][1] = bfhi(L.x); hv[k][2] = bflo(L.y); hv[k][3] = bfhi(L.y); hv[k][4] = bflo(L.z); hv[k][5] = bfhi(L.z); hv[k][6] = bflo(L.w); hv[k][7] = bfhi(L.w);
                if (zero0) {
#pragma unroll
                    for (int j = 0; j < 8; ++j) hv[k][j] = 0.f; } }
        }
        float w[4][8], bb[8];
#pragma unroll
        for (int k = 0; k < 4; ++k) { const f32x4 a = *(const f32x4*)(p.conv_w + k * CONVD + cc), b = *(const f32x4*)(p.conv_w + k * CONVD + cc + 4);
            w[k][0] = a[0]; w[k][1] = a[1]; w[k][2] = a[2]; w[k][3] = a[3]; w[k][4] = b[0]; w[k][5] = b[1]; w[k][6] = b[2]; w[k][7] = b[3]; }
        { const f32x4 a = *(const f32x4*)(p.conv_b + cc), b = *(const f32x4*)(p.conv_b + cc + 4); bb[0] = a[0]; bb[1] = a[1]; bb[2] = a[2]; bb[3] = a[3]; bb[4] = b[0]; bb[5] = b[1]; bb[6] = b[2]; bb[7] = b[3]; }
#pragma unroll
        for (int i = 0; i < 8; ++i) { float o[8];
#pragma unroll
            for (int j = 0; j < 8; ++j) o[j] = bb[j];
#pragma unroll
            for (int k = 0; k < 4; ++k) { const int rk = i + k;
                float x[8];
                if (rk < 3) {
#pragma unroll
                    for (int j = 0; j < 8; ++j) x[j] = hv[rk][j];
                } else { const u32x4 L = r.L[rk]; x[0] = bflo(L.x); x[1] = bfhi(L.x); x[2] = bflo(L.y); x[3] = bfhi(L.y); x[4] = bflo(L.z); x[5] = bfhi(L.z); x[6] = bflo(L.w); x[7] = bfhi(L.w); }
#pragma unroll
                for (int j = 0; j < 8; ++j) o[j] += x[j] * w[k][j]; }
#pragma unroll
            for (int j = 0; j < 8; ++j) o[j] = siluf_(o[j]);
            u32x4 q; q.x = pk2(o[0], o[1]); q.y = pk2(o[2], o[3]); q.z = pk2(o[4], o[5]); q.w = pk2(o[6], o[7]);
            *(u32x4*)(XACT + (size_t)(r0 + i) * CONVD + cc) = q; }
        float* cst = nullptr;
        if (smp) cst = p.out + O_CS + (size_t)s * 3 * CONVD + cc;
        else if ((run % (TP / 8)) == TP / 8 - 1) cst = p.out + O_CP + (size_t)(run / (TP / 8)) * 3 * CONVD + cc;
        if (cst) {
#pragma unroll
            for (int j = 0; j < 3; ++j) { const u32x4 L = r.L[8 + j];
                *(f32x4*)(cst + j * CONVD) = (f32x4){bflo(L.x), bfhi(L.x), bflo(L.y), bfhi(L.y)}; *(f32x4*)(cst + j * CONVD + 4) = (f32x4){bflo(L.z), bfhi(L.z), bflo(L.w), bfhi(L.w)}; } }
    };
    {
        const int NIT = NRUN * NCG, stride = gridDim.x * 512;
        int item = blockIdx.x * 512 + tid;
        Raw ra, rb;
        if (item < NIT) load_raw(item, ra);
        while (item < NIT) {
            int nxt = item + stride;
            if (nxt < NIT) load_raw(nxt, rb);
            compute(item, ra);
            item = nxt;
            if (item < NIT) { nxt = item + stride; if (nxt < NIT) load_raw(nxt, ra); compute(item, rb); item = nxt; }
        }
    }
    const float* DTR = (const float*)(p.ws + W_DTRAW); float* DT = (float*)(p.ws + W_DT); float* AC = (float*)(p.ws + W_AC);
    { const int wid = tid >> 6, lane = tid & 63;
      for (int it = blockIdx.x * 8 + wid; it < 68 * 32; it += gridDim.x * 8) { const int ch = it >> 5, h = it & 31;
          const size_t r0 = (size_t)ch * 128 + 2 * lane; const int tseq = (ch % 17) * 128 + 2 * lane;
          float d0 = softplusf_(DTR[r0 * 32 + h] + p.dt_bias[h]), d1 = softplusf_(DTR[(r0 + 1) * 32 + h] + p.dt_bias[h]);
          if (tseq < PADR) d0 = 0.f; if (tseq + 1 < PADR) d1 = 0.f;
          const float a = -__expf(p.a_log[h]), v0 = d0 * a, v1 = d1 * a, s = v0 + v1; float incl = s;
#pragma unroll
          for (int o = 1; o < 64; o <<= 1) { const float nb = __shfl_up(incl, o); if (lane >= o) incl += nb; }
          const float excl = incl - s;
          DT[r0 * 32 + h] = d0; DT[(r0 + 1) * 32 + h] = d1; AC[r0 * 32 + h] = excl + v0; AC[(r0 + 1) * 32 + h] = excl + s; } }
    for (int e = ROWS_P * 32 + blockIdx.x * 512 + tid; e < TROWS * 32; e += gridDim.x * 512) DT[e] = softplusf_(DTR[e] + p.dt_bias[e & 31]);
}

typedef short s16x4 __attribute__((ext_vector_type(4)));
constexpr int XROW = 72, LROW = 136;
__device__ __forceinline__ u32x2 tr4(LAS bf16_t* img, int stride, int R0, int col0, int fr) {
    const s16x4 v = __builtin_amdgcn_ds_read_tr16_b64_v4i16((LAS s16x4*)(img + (R0 + (fr >> 2)) * stride + col0 + 4 * (fr & 3)));
    return __builtin_bit_cast(u32x2, v);
}
__device__ __forceinline__ void ssd_prompt(const Params& p, LAS unsigned char* lds, int b, int h) {
    const int tid = tid_opaque(), wid = __builtin_amdgcn_readfirstlane(tid >> 6), lane = tid & 63, fr = lane & 15, fq = lane >> 4;
    const int g = h >> 3;
    LAS bf16_t* sX = (LAS bf16_t*)(lds);
    LAS bf16_t* sB = (LAS bf16_t*)(lds + 18432);
    LAS bf16_t* sC = (LAS bf16_t*)(lds + 53248);
    LAS bf16_t* sH = (LAS bf16_t*)(lds + 88064);
    LAS float* sDt = (LAS float*)(lds + 105472);
    LAS float* sAc = sDt + 128;
    LAS float* sW = sAc + 128;
    const bf16_t* PROJ = (const bf16_t*)(p.ws + W_PROJ);
    const bf16_t* XACT = (const bf16_t*)(p.ws + W_XACT);
    const float* DT = (const float*)(p.ws + W_DT);
    const float* AC = (const float*)(p.ws + W_AC);
    bf16_t* A2 = (bf16_t*)(p.ws + W_A2);
    float* YSS = (float*)(p.ws + W_YSS);
    const float Dh = p.d_skip[h];
    for (int i = tid; i < 64 * LROW / 2; i += 512) ((LAS unsigned*)sH)[i] = 0u;
    f32x4 hacc[4];
#pragma unroll
    for (int i = 0; i < 4; ++i) hacc[i] = (f32x4){0.f, 0.f, 0.f, 0.f};
    const int trow = 16 * wid + fr;
    u32x4 rx[2], rb[4], rc[4]; u32x2 rz[4]; float rd0 = 0.f, rd1 = 0.f, ra0 = 0.f, ra1 = 0.f;
#define SSD_ISSUE(cn) do { const size_t nb_ = (size_t)b * TP + (size_t)(cn) * 128; \
        _Pragma("unroll") for (int i = 0; i < 2; ++i) { const int v_ = tid + 512 * i; rx[i] = __builtin_nontemporal_load((const u32x4*)(XACT + (nb_ + (v_ >> 3)) * CONVD + h * 64 + (v_ & 7) * 8)); } \
        _Pragma("unroll") for (int i = 0; i < 4; ++i) { const int v_ = tid + 512 * i; const bf16_t* q_ = XACT + (nb_ + (v_ >> 4)) * CONVD + 2048 + g * 128 + (v_ & 15) * 8; rb[i] = *(const u32x4*)q_; rc[i] = *(const u32x4*)(q_ + 512); } \
        if (wid == 0) { rd0 = DT[(nb_ + 2 * lane) * 32 + h]; rd1 = DT[(nb_ + 2 * lane + 1) * 32 + h]; ra0 = AC[(nb_ + 2 * lane) * 32 + h]; ra1 = AC[(nb_ + 2 * lane + 1) * 32 + h]; } } while (0)
#define SSD_ISSUE_Z(cn) do { const bf16_t* q_ = PROJ + ((size_t)b * TP + (size_t)(cn) * 128 + trow) * NPROJ + C_Z + h * 64 + 4 * fq; \
        _Pragma("unroll") for (int pt = 0; pt < 4; ++pt) rz[pt] = __builtin_nontemporal_load((const u32x2*)(q_ + 16 * pt)); } while (0)
    SSD_ISSUE(0); SSD_ISSUE_Z(0);
    for (int c = 0; c < 17; ++c) {
        const int base = b * TP + c * 128;
        if (wid == 0) { const int t0 = 2 * lane; sDt[t0] = rd0; sDt[t0 + 1] = rd1; sAc[t0] = ra0; sAc[t0 + 1] = ra1; }
#pragma unroll
        for (int i = 0; i < 2; ++i) { const int v_ = tid + 512 * i; *(LAS u32x4*)(sX + (v_ >> 3) * XROW + (v_ & 7) * 8) = rx[i]; }
#pragma unroll
        for (int i = 0; i < 4; ++i) { const int v_ = tid + 512 * i; *(LAS u32x4*)(sB + (v_ >> 4) * LROW + (v_ & 15) * 8) = rb[i]; *(LAS u32x4*)(sC + (v_ >> 4) * LROW + (v_ & 15) * 8) = rc[i]; }
        __syncthreads();
        const int cn = c < 16 ? c + 1 : 16;
        SSD_ISSUE(cn);
        if (tid < 128) sW[tid] = __expf(sAc[127] - sAc[tid]) * sDt[tid];
        const float act = sAc[trow];
        bf16x8 cf[4];
#pragma unroll
        for (int kk = 0; kk < 4; ++kk) cf[kk] = *(const LAS bf16x8*)(sC + trow * LROW + 32 * kk + 8 * fq);
        f32x4 d[8];
#pragma unroll
        for (int st = 0; st < 8; ++st) d[st] = (f32x4){0.f, 0.f, 0.f, 0.f};
#pragma unroll
        for (int kk = 0; kk < 4; ++kk) {
            bf16x8 bfr[8];
#pragma unroll
            for (int st = 0; st < 8; ++st) bfr[st] = *(const LAS bf16x8*)(sB + (16 * st + fr) * LROW + 32 * kk + 8 * fq);
#pragma unroll
            for (int st = 0; st < 8; ++st) d[st] = __builtin_amdgcn_mfma_f32_16x16x32_bf16(bfr[st], cf[kk], d[st], 0, 0, 0);
        }
        bf16x8 gfrag[4];
        {
#pragma unroll
            for (int kb = 0; kb < 4; ++kb) {
                f32x4 acs[2], dts[2];
#pragma unroll
                for (int hf = 0; hf < 2; ++hf) { acs[hf] = *(const LAS f32x4*)(sAc + 16 * (2 * kb + hf) + 4 * fq); dts[hf] = *(const LAS f32x4*)(sDt + 16 * (2 * kb + hf) + 4 * fq); }
                unsigned pkd[4];
#pragma unroll
                for (int hf = 0; hf < 2; ++hf) { const int st = 2 * kb + hf; float gv[4];
#pragma unroll
                    for (int jj = 0; jj < 4; ++jj) { const int s = 16 * st + 4 * fq + jj; gv[jj] = (s <= trow) ? d[st][jj] * __expf(act - acs[hf][jj]) * dts[hf][jj] : 0.f; }
                    pkd[2 * hf] = pk2(gv[0], gv[1]); pkd[2 * hf + 1] = pk2(gv[2], gv[3]); }
                u32x4 w; w.x = pkd[0]; w.y = pkd[1]; w.z = pkd[2]; w.w = pkd[3];
                gfrag[kb] = __builtin_bit_cast(bf16x8, w);
            }
        }
        const float eact = __expf(act);
        const int grow = base + trow;
        f32x4 y[4];
#pragma unroll
        for (int pt = 0; pt < 4; ++pt) y[pt] = (f32x4){0.f, 0.f, 0.f, 0.f};
#pragma unroll
        for (int kk = 0; kk < 4; ++kk) {
            bf16x8 hf[4];
#pragma unroll
            for (int pt = 0; pt < 4; ++pt) hf[pt] = *(const LAS bf16x8*)(sH + (16 * pt + fr) * LROW + 32 * kk + 8 * fq);
#pragma unroll
            for (int pt = 0; pt < 4; ++pt) y[pt] = __builtin_amdgcn_mfma_f32_16x16x32_bf16(hf[pt], cf[kk], y[pt], 0, 0, 0);
        }
#pragma unroll
        for (int pt = 0; pt < 4; ++pt) y[pt] *= eact;
#pragma unroll
        for (int kb = 0; kb < 4; ++kb) {
            u32x2 x0[4], x1[4];
#pragma unroll
            for (int pt = 0; pt < 4; ++pt) { x0[pt] = tr4(sX, XROW, 32 * kb + 4 * fq, 16 * pt, fr); x1[pt] = tr4(sX, XROW, 32 * kb + 16 + 4 * fq, 16 * pt, fr); }
#pragma unroll
            for (int pt = 0; pt < 4; ++pt) { u32x4 w; w.x = x0[pt].x; w.y = x0[pt].y; w.z = x1[pt].x; w.w = x1[pt].y;
                y[pt] = __builtin_amdgcn_mfma_f32_16x16x32_bf16(__builtin_bit_cast(bf16x8, w), gfrag[kb], y[pt], 0, 0, 0); }
        }
        float ssq = 0.f;
        {
            u32x2 xx[4];
#pragma unroll
            for (int pt = 0; pt < 4; ++pt) xx[pt] = *(const LAS u32x2*)(sX + trow * XROW + 16 * pt + 4 * fq);
#pragma unroll
            for (int pt = 0; pt < 4; ++pt) {
                const int pc = 16 * pt + 4 * fq;
                const float zf[4] = {bflo(rz[pt].x), bfhi(rz[pt].x), bflo(rz[pt].y), bfhi(rz[pt].y)};
                const float xf[4] = {bflo(xx[pt].x), bfhi(xx[pt].x), bflo(xx[pt].y), bfhi(xx[pt].y)};
                float yo[4];
#pragma unroll
                for (int jj = 0; jj < 4; ++jj) { const float v = (y[pt][jj] + Dh * xf[jj]) * siluf_(zf[jj]); yo[jj] = v; ssq += v * v; }
                u32x2 w; w.x = pk2(yo[0], yo[1]); w.y = pk2(yo[2], yo[3]);
                *(u32x2*)(A2 + (size_t)grow * 4096 + h * 64 + pc) = w;
            }
        }
        ssq += __shfl_xor(ssq, 16); ssq += __shfl_xor(ssq, 32);
        if (fq == 0) YSS[(size_t)grow * 32 + h] = ssq;
        SSD_ISSUE_Z(cn);
        __syncthreads();
        {
            const float dec = __expf(sAc[127]);
            const int ptile = wid & 3, nt0 = (wid >> 2) * 4;
#pragma unroll
            for (int i = 0; i < 4; ++i) hacc[i] *= dec;
#pragma unroll
            for (int kk = 0; kk < 4; ++kk) {
                const int sb = 32 * kk + 8 * fq;
                const u32x2 xlo = tr4(sX, XROW, sb, 16 * ptile, fr), xhi = tr4(sX, XROW, sb + 4, 16 * ptile, fr);
                const f32x4 w0 = *(const LAS f32x4*)(sW + sb), w1 = *(const LAS f32x4*)(sW + sb + 4);
                u32x2 blo[4], bhi[4];
#pragma unroll
                for (int i = 0; i < 4; ++i) { blo[i] = tr4(sB, LROW, sb, 16 * (nt0 + i), fr); bhi[i] = tr4(sB, LROW, sb + 4, 16 * (nt0 + i), fr); }
                u32x4 w;
                w.x = pk2(bflo(xlo.x) * w0[0], bfhi(xlo.x) * w0[1]); w.y = pk2(bflo(xlo.y) * w0[2], bfhi(xlo.y) * w0[3]);
                w.z = pk2(bflo(xhi.x) * w1[0], bfhi(xhi.x) * w1[1]); w.w = pk2(bflo(xhi.y) * w1[2], bfhi(xhi.y) * w1[3]);
                const bf16x8 xa = __builtin_bit_cast(bf16x8, w);
#pragma unroll
                for (int i = 0; i < 4; ++i) { u32x4 bw; bw.x = blo[i].x; bw.y = blo[i].y; bw.z = bhi[i].x; bw.w = bhi[i].y;
                    hacc[i] = __builtin_amdgcn_mfma_f32_16x16x32_bf16(xa, __builtin_bit_cast(bf16x8, bw), hacc[i], 0, 0, 0); }
            }
#pragma unroll
            for (int i = 0; i < 4; ++i)
#pragma unroll
                for (int jj = 0; jj < 4; ++jj) sH[(16 * ptile + 4 * fq + jj) * LROW + 16 * (nt0 + i) + fr] = f2bf(hacc[i][jj]);
        }
        __syncthreads();
    }
#undef SSD_ISSUE
#undef SSD_ISSUE_Z
    { const int ptile = wid & 3, nt0 = (wid >> 2) * 4; float* dst = p.out + O_SP + ((size_t)(b * 32 + h) * 64) * 128;
#pragma unroll
        for (int i = 0; i < 4; ++i)
#pragma unroll
            for (int jj = 0; jj < 4; ++jj) dst[(16 * ptile + 4 * fq + jj) * 128 + 16 * (nt0 + i) + fr] = hacc[i][jj]; }
}

__device__ __forceinline__ void ssd_sample(const Params& p, LAS unsigned char* lds, int s, int g) {
    const int tid = tid_opaque(), wid = __builtin_amdgcn_readfirstlane(tid >> 6), lane = tid & 63, fr = lane & 15, fq = lane >> 4;
    LAS bf16_t* sXT = (LAS bf16_t*)(lds);
    LAS bf16_t* sBT = (LAS bf16_t*)(lds + 8192);
    LAS bf16_t* sBn = (LAS bf16_t*)(lds + 10240);
    LAS bf16_t* sCn = (LAS bf16_t*)(lds + 12288);
    LAS float* sCB = (LAS float*)(lds + 14336);
    LAS float* sDt2 = sCB + 64;
    LAS float* sAc2 = sDt2 + 64;
    const bf16_t* PROJ = (const bf16_t*)(p.ws + W_PROJ);
    const bf16_t* XACT = (const bf16_t*)(p.ws + W_XACT);
    const float* DT = (const float*)(p.ws + W_DT);
    bf16_t* A2 = (bf16_t*)(p.ws + W_A2);
    float* YSS = (float*)(p.ws + W_YSS);
    const int rbase = ROWS_P + s * 8;
    const int h = g * 8 + wid;
    const float* hsrc = p.state_ssm + ((size_t)s * 32 + h) * 8192 + (size_t)fr * 128 + 4 * fq;
    float* hdst = p.out + O_SS + ((size_t)s * 32 + h) * 8192 + (size_t)fr * 128 + 4 * fq;
    f32x4 ha[8], hb[8];
#define SMP_LOADH(dst, pt) do { _Pragma("unroll") for (int nt = 0; nt < 8; ++nt) dst[nt] = __builtin_nontemporal_load((const f32x4*)(hsrc + (pt) * 2048 + nt * 16)); } while (0)
    SMP_LOADH(ha, 0);
    float zv[4][4];
#pragma unroll
    for (int jj = 0; jj < 4; ++jj)
#pragma unroll
        for (int pt = 0; pt < 4; ++pt) zv[jj][pt] = bf2f(PROJ[(size_t)(rbase + ((4 * fq + jj) & 7)) * NPROJ + C_Z + h * 64 + 16 * pt + fr]);
    __builtin_amdgcn_sched_barrier(0);
    { const int row = tid >> 6, cgx = tid & 63; const u32x4 L = *(const u32x4*)(XACT + (size_t)(rbase + row) * CONVD + g * 512 + cgx * 8);
        LAS bf16_t* d = sXT + (cgx * 8) * 8 + row;
        d[0] = (bf16_t)(L.x & 0xffffu); d[8] = (bf16_t)(L.x >> 16); d[16] = (bf16_t)(L.y & 0xffffu); d[24] = (bf16_t)(L.y >> 16);
        d[32] = (bf16_t)(L.z & 0xffffu); d[40] = (bf16_t)(L.z >> 16); d[48] = (bf16_t)(L.w & 0xffffu); d[56] = (bf16_t)(L.w >> 16); }
    if (tid < 256) { const int which = tid >> 7, v = tid & 127, row = v >> 4, cg = v & 15;
        const u32x4 L = *(const u32x4*)(XACT + (size_t)(rbase + row) * CONVD + 2048 + which * 512 + g * 128 + cg * 8);
        *(LAS u32x4*)((which ? sCn : sBn) + row * 128 + cg * 8) = L;
        if (which == 0) { LAS bf16_t* d = sBT + (cg * 8) * 8 + row;
            d[0] = (bf16_t)(L.x & 0xffffu); d[8] = (bf16_t)(L.x >> 16); d[16] = (bf16_t)(L.y & 0xffffu); d[24] = (bf16_t)(L.y >> 16);
            d[32] = (bf16_t)(L.z & 0xffffu); d[40] = (bf16_t)(L.z >> 16); d[48] = (bf16_t)(L.w & 0xffffu); d[56] = (bf16_t)(L.w >> 16); } }
    else if (tid < 320) { const int l = tid - 256, hh = l >> 3, t = l & 7, h2 = g * 8 + hh;
        const float dt = DT[(size_t)(rbase + t) * 32 + h2];
        float v = dt * (-__expf(p.a_log[h2]));
#pragma unroll
        for (int o = 1; o < 8; o <<= 1) { const float nb = __shfl_up(v, o, 8); if (t >= o) v += nb; }
        sDt2[l] = dt; sAc2[l] = v; }
    __syncthreads();
    { const int pair = tid >> 3, part = tid & 7, t = pair >> 3, s2 = pair & 7; float d = 0.f;
        const u32x4 c0 = *(const LAS u32x4*)(sCn + t * 128 + 16 * part), c1 = *(const LAS u32x4*)(sCn + t * 128 + 16 * part + 8);
        const u32x4 b0 = *(const LAS u32x4*)(sBn + s2 * 128 + 16 * part), b1 = *(const LAS u32x4*)(sBn + s2 * 128 + 16 * part + 8);
        d += bflo(c0.x) * bflo(b0.x) + bfhi(c0.x) * bfhi(b0.x) + bflo(c0.y) * bflo(b0.y) + bfhi(c0.y) * bfhi(b0.y) + bflo(c0.z) * bflo(b0.z) + bfhi(c0.z) * bfhi(b0.z) + bflo(c0.w) * bflo(b0.w) + bfhi(c0.w) * bfhi(b0.w);
        d += bflo(c1.x) * bflo(b1.x) + bfhi(c1.x) * bfhi(b1.x) + bflo(c1.y) * bflo(b1.y) + bfhi(c1.y) * bfhi(b1.y) + bflo(c1.z) * bflo(b1.z) + bfhi(c1.z) * bfhi(b1.z) + bflo(c1.w) * bflo(b1.w) + bfhi(c1.w) * bfhi(b1.w);
        d += __shfl_xor(d, 1); d += __shfl_xor(d, 2); d += __shfl_xor(d, 4);
        if (part == 0) sCB[pair] = d; }
    __syncthreads();
    const int tl = fr & 7;
    float ac[8], dtv[8];
    { const f32x4 a0 = *(const LAS f32x4*)(sAc2 + wid * 8), a1 = *(const LAS f32x4*)(sAc2 + wid * 8 + 4), d0 = *(const LAS f32x4*)(sDt2 + wid * 8), d1 = *(const LAS f32x4*)(sDt2 + wid * 8 + 4);
#pragma unroll
      for (int t = 0; t < 4; ++t) { ac[t] = a0[t]; ac[4 + t] = a1[t]; dtv[t] = d0[t]; dtv[4 + t] = d1[t]; } }
    const float aT = ac[7], dec = __expf(aT), Dh = p.d_skip[h];
    float wv[8];
#pragma unroll
    for (int s2 = 0; s2 < 8; ++s2) wv[s2] = __expf(aT - ac[s2]) * dtv[s2];
    bf16x8 gfrag;
    { float actl = ac[0];
#pragma unroll
      for (int k = 1; k < 8; ++k) actl = (tl == k) ? ac[k] : actl;
      const f32x4 cb0 = *(const LAS f32x4*)(sCB + tl * 8), cb1 = *(const LAS f32x4*)(sCB + tl * 8 + 4);
      float gv[8];
#pragma unroll
      for (int s2 = 0; s2 < 8; ++s2) { const float cbv = s2 < 4 ? cb0[s2 & 3] : cb1[s2 & 3]; gv[s2] = (s2 <= tl && fq == 0) ? cbv * __expf(fminf(actl - ac[s2], 0.f)) * dtv[s2] : 0.f; }
      u32x4 w; w.x = pk2(gv[0], gv[1]); w.y = pk2(gv[2], gv[3]); w.z = pk2(gv[4], gv[5]); w.w = pk2(gv[6], gv[7]); gfrag = __builtin_bit_cast(bf16x8, w); }
    bf16x8 cfrag[4];
#pragma unroll
    for (int kk = 0; kk < 4; ++kk) { const u32x2 lo = *(const LAS u32x2*)(sCn + tl * 128 + 32 * kk + 4 * fq), hi = *(const LAS u32x2*)(sCn + tl * 128 + 32 * kk + 16 + 4 * fq);
        u32x4 w; w.x = lo.x; w.y = lo.y; w.z = hi.x; w.w = hi.y; cfrag[kk] = __builtin_bit_cast(bf16x8, w); }
    bf16x8 btf[8];
#pragma unroll
    for (int nt = 0; nt < 8; ++nt) { u32x4 w = *(const LAS u32x4*)(sBT + (16 * nt + fr) * 8); if (fq != 0) w = (u32x4){0u, 0u, 0u, 0u}; btf[nt] = __builtin_bit_cast(bf16x8, w); }
    float eact[4];
#pragma unroll
    for (int jj = 0; jj < 4; ++jj) { float a_ = ac[0];
#pragma unroll
        for (int k = 1; k < 8; ++k) a_ = (((4 * fq + jj) & 7) == k) ? ac[k] : a_;
        eact[jj] = __expf(a_); }
    float ssq[4] = {0.f, 0.f, 0.f, 0.f};
    auto ptile = [&](const f32x4 (&hv)[8], int pt) {
        const u32x4 xr = *(const LAS u32x4*)(sXT + (wid * 64 + 16 * pt + fr) * 8);
        const float xf[8] = {bflo(xr.x), bfhi(xr.x), bflo(xr.y), bfhi(xr.y), bflo(xr.z), bfhi(xr.z), bflo(xr.w), bfhi(xr.w)};
        f32x4 y = (f32x4){0.f, 0.f, 0.f, 0.f};
#pragma unroll
        for (int kk = 0; kk < 4; ++kk) { u32x4 w; w.x = pk2(hv[2 * kk][0], hv[2 * kk][1]); w.y = pk2(hv[2 * kk][2], hv[2 * kk][3]); w.z = pk2(hv[2 * kk + 1][0], hv[2 * kk + 1][1]); w.w = pk2(hv[2 * kk + 1][2], hv[2 * kk + 1][3]);
            y = __builtin_amdgcn_mfma_f32_16x16x32_bf16(cfrag[kk], __builtin_bit_cast(bf16x8, w), y, 0, 0, 0); }
#pragma unroll
        for (int jj = 0; jj < 4; ++jj) y[jj] *= eact[jj];
        { u32x4 w = fq == 0 ? xr : (u32x4){0u, 0u, 0u, 0u}; y = __builtin_amdgcn_mfma_f32_16x16x32_bf16(gfrag, __builtin_bit_cast(bf16x8, w), y, 0, 0, 0); }
        if (fq < 2) {
            float xt[4];
#pragma unroll
            for (int jj = 0; jj < 4; ++jj) xt[jj] = fq == 0 ? xf[jj] : xf[4 + jj];
#pragma unroll
            for (int jj = 0; jj < 4; ++jj) { const float v = (y[jj] + Dh * xt[jj]) * siluf_(zv[jj][pt]); ssq[jj] += v * v;
                A2[(size_t)(rbase + 4 * fq + jj) * 4096 + h * 64 + 16 * pt + fr] = f2bf(v); }
        }
        u32x4 xw; xw.x = pk2(xf[0] * wv[0], xf[1] * wv[1]); xw.y = pk2(xf[2] * wv[2], xf[3] * wv[3]); xw.z = pk2(xf[4] * wv[4], xf[5] * wv[5]); xw.w = pk2(xf[6] * wv[6], xf[7] * wv[7]);
        if (fq != 0) xw = (u32x4){0u, 0u, 0u, 0u};
        const bf16x8 xwf = __builtin_bit_cast(bf16x8, xw);
#pragma unroll
        for (int nt = 0; nt < 8; ++nt) { f32x4 acc = hv[nt] * dec; acc = __builtin_amdgcn_mfma_f32_16x16x32_bf16(btf[nt], xwf, acc, 0, 0, 0);
            *(f32x4*)(hdst + pt * 2048 + nt * 16) = acc; }
    };
    SMP_LOADH(hb, 1); __builtin_amdgcn_sched_barrier(0);
    ptile(ha, 0); SMP_LOADH(ha, 2); __builtin_amdgcn_sched_barrier(0);
    ptile(hb, 1); SMP_LOADH(hb, 3); __builtin_amdgcn_sched_barrier(0);
    ptile(ha, 2); __builtin_amdgcn_sched_barrier(0);
    ptile(hb, 3);
#undef SMP_LOADH
#pragma unroll
    for (int jj = 0; jj < 4; ++jj) { float v = ssq[jj]; v += __shfl_xor(v, 1); v += __shfl_xor(v, 2); v += __shfl_xor(v, 4); v += __shfl_xor(v, 8); ssq[jj] = v; }
    if (fr == 0 && fq < 2) {
#pragma unroll
        for (int jj = 0; jj < 4; ++jj) YSS[(size_t)(rbase + 4 * fq + jj) * 32 + h] = ssq[jj]; }
    __syncthreads();
}
__device__ __forceinline__ void phase_elem(const Params& p, unsigned char* smem) {
    phase_conv(p);
    for (int it = blockIdx.x; it < 544 + 512; it += gridDim.x) {
        if (it < 544) pool_prompt(p, smem, it / 136, (it % 136) >> 2, it & 3);
        else { const int j = it - 544; pool_sample(p, j >> 2, j & 3); }
    }
}
__device__ __forceinline__ void phase_ssd(const Params& p, unsigned char* smem) {
    const int G = gridDim.x, bid = blockIdx.x;
    if (bid < 128) {
        const int xcd = bid & 7, slot = bid >> 3, pair = xcd * 2 + (slot >> 3);
        ssd_prompt(p, (LAS unsigned char*)smem, pair >> 2, (pair & 3) * 8 + (slot & 7)); }
    else for (int it = bid - 128; it < 512; it += G - 128) ssd_sample(p, (LAS unsigned char*)smem, it >> 2, it & 3);
}

__device__ __forceinline__ void phase_ynorm(const Params& p, int vbid, int vG) {
    const int tid = tid_opaque(); const int wid = tid >> 6, lane = tid & 63;
    bf16_t* A2 = (bf16_t*)(p.ws + W_A2); const float* YSS = (const float*)(p.ws + W_YSS);
    for (int it = vbid * 8 + wid; it < TROWS * 4; it += vG * 8) {
        const int row = it >> 2, g = it & 3;
        const f32x4 s0 = *(const f32x4*)(YSS + (size_t)row * 32 + g * 8), s1 = *(const f32x4*)(YSS + (size_t)row * 32 + g * 8 + 4);
        const float ss = s0[0] + s0[1] + s0[2] + s0[3] + s1[0] + s1[1] + s1[2] + s1[3];
        const float rs = rsqrtf(ss * (1.0f / 512.0f) + EPS);
        bf16_t* ptr = A2 + (size_t)row * 4096 + g * 512 + lane * 8;
        const u32x4 v = *(const u32x4*)ptr;
        const f32x4 w0 = *(const f32x4*)(p.ssd_norm_w + g * 512 + lane * 8), w1 = *(const f32x4*)(p.ssd_norm_w + g * 512 + lane * 8 + 4);
        u32x4 o; o.x = pk2(bflo(v.x) * rs * w0[0], bfhi(v.x) * rs * w0[1]); o.y = pk2(bflo(v.y) * rs * w0[2], bfhi(v.y) * rs * w0[3]);
        o.z = pk2(bflo(v.z) * rs * w1[0], bfhi(v.z) * rs * w1[1]); o.w = pk2(bflo(v.w) * rs * w1[2], bfhi(v.w) * rs * w1[3]);
        *(u32x4*)ptr = o;
    }
}
__device__ __forceinline__ void phase_final(const Params& p, int rb, int re, int vbid, int vG) {
    const int tid = tid_opaque(); const int wid = tid >> 6, lane = tid & 63;
    const float* RSS = (const float*)(p.ws + W_RSS);
    for (int r = rb + vbid * 8 + wid; r < re; r += vG * 8) {
        float* dst = row_dst(p, r); if (!dst) continue;
        float ss = lane < 32 ? RSS[(size_t)r * 32 + lane] : 0.f;
#pragma unroll
        for (int o = 32; o >= 1; o >>= 1) ss += __shfl_xor(ss, o);
        const float rs = rsqrtf(ss * (1.0f / DM) + EPS);
#pragma unroll
        for (int i = 0; i < 8; ++i) { f32x4 v = ((f32x4*)dst)[lane + 64 * i]; const f32x4 w = ((const f32x4*)p.final_norm_w)[lane + 64 * i];
            v[0] *= rs * w[0]; v[1] *= rs * w[1]; v[2] *= rs * w[2]; v[3] *= rs * w[3]; ((f32x4*)dst)[lane + 64 * i] = v; }
    }
}


#define XB_TMO      128
#define XB_XCNT(j)  (256  + 64 * (j))
#define XB_XSUB(j)  (1280 + 64 * (j))
#define XB_XGEN(j)  (2304 + 64 * (j))
#define XB_TOP      3328
#define XB_TOPGEN   3392
#define XCD_BAR_WORDS 3456
#define XB_SPIN_CAP (1u << 18)
__device__ __forceinline__ unsigned xb_ld(unsigned* p)              { return __hip_atomic_load(p, __ATOMIC_RELAXED, __HIP_MEMORY_SCOPE_AGENT); }
__device__ __forceinline__ unsigned xb_add(unsigned* p, unsigned v) { return __hip_atomic_fetch_add(p, v, __ATOMIC_RELAXED, __HIP_MEMORY_SCOPE_AGENT); }
__device__ __forceinline__ unsigned xb_xcc_id() { return (unsigned)__builtin_amdgcn_s_getreg((3 << 11) | 20) & 0xFu; }
#define XB_SPIN(cond, bar) do { unsigned _sp = 0; while (cond) { __builtin_amdgcn_s_sleep(1); \
    if ((++_sp & 255u) == 0u) { if (xb_ld(&(bar)[XB_TMO])) break; if (_sp > XB_SPIN_CAP) { atomicAdd(&(bar)[XB_TMO], 1u); break; } } } } while (0)
struct XcdBarrier { unsigned* bar; unsigned x; volatile LAS unsigned* st; };
__device__ __forceinline__ XcdBarrier xcd_barrier_post(unsigned* bar, volatile LAS unsigned* st) {
    XcdBarrier b; b.bar = bar; b.x = xb_xcc_id(); b.st = st;
    if (threadIdx.x == 0) (void)xb_add(&bar[XB_XCNT(b.x)], 1u);
    return b;
}
__device__ __forceinline__ void xcd_barrier_complete(unsigned* bar, unsigned x, unsigned& nloc, unsigned& nx) {
    const unsigned G = gridDim.x * gridDim.y * gridDim.z;
    unsigned sum, cnt, mine, sp = 0u;
    for (;;) {
        sum = 0u; cnt = 0u; mine = 0u;
#pragma unroll
        for (unsigned j = 0; j < 16; ++j) { const unsigned c = xb_ld(&bar[XB_XCNT(j)]); sum += c; cnt += (c > 0u) ? 1u : 0u; mine = (j == x) ? c : mine; }
        if (sum == G) break;
        __builtin_amdgcn_s_sleep(1);
        if ((++sp & 255u) == 0u) { if (xb_ld(&bar[XB_TMO])) break; if (sp > XB_SPIN_CAP) { atomicAdd(&bar[XB_TMO], 1u); break; } }
    }
    nloc = mine > 0u ? mine : 1u; nx = cnt > 0u ? cnt : 1u;
}
__device__ __forceinline__ void xcd_barrier(const XcdBarrier& b) {
    asm volatile("s_waitcnt vmcnt(0)" ::: "memory");
    __syncthreads();
    if (threadIdx.x == 0) {
        unsigned* bar = b.bar;
        __builtin_amdgcn_s_waitcnt(0);
        unsigned nloc = b.st[0], nx = b.st[1];
        if (nloc == 0u) { xcd_barrier_complete(bar, b.x, nloc, nx); b.st[0] = nloc; b.st[1] = nx; }
        const unsigned old = xb_add(&bar[XB_XSUB(b.x)], 1u);
        const unsigned gen = old / nloc;
        if (old + 1u == (gen + 1u) * nloc) {
            __builtin_amdgcn_fence(__ATOMIC_RELEASE, "agent");
            asm volatile("s_waitcnt vmcnt(0)" ::: "memory");
            const unsigned og = xb_add(&bar[XB_TOP], 1u);
            const unsigned tg = og / nx;
            if (og + 1u == (tg + 1u) * nx) xb_add(&bar[XB_TOPGEN], 1u);
            else XB_SPIN(xb_ld(&bar[XB_TOPGEN]) == tg, bar);
            __builtin_amdgcn_fence(__ATOMIC_ACQUIRE, "agent");
            xb_add(&bar[XB_XGEN(b.x)], 1u);
            asm volatile("s_waitcnt vmcnt(0)" ::: "memory");
        } else {
            XB_SPIN(xb_ld(&bar[XB_XGEN(b.x)]) == gen, bar);
            __builtin_amdgcn_fence(__ATOMIC_ACQUIRE, "agent");
            asm volatile("s_waitcnt vmcnt(0)" ::: "memory");
        }
    }
    __syncthreads();
}

__global__ void __launch_bounds__(512, 2) fwd_megakernel(Params p) {
    extern __shared__ __attribute__((aligned(16))) unsigned char shm[];
    cg::grid_group grid = cg::this_grid();
    LAS unsigned char* lds = (LAS unsigned char*)shm;
    bf16_t* XN = (bf16_t*)(p.ws + W_XN); bf16_t* PROJ = (bf16_t*)(p.ws + W_PROJ); bf16_t* A2 = (bf16_t*)(p.ws + W_A2);
    volatile LAS unsigned* xst = (volatile LAS unsigned*)(lds + LDS_BYTES - 16);
    if (threadIdx.x == 0) { xst[0] = 0u; xst[1] = 0u; }
    __syncthreads();
    if (blockIdx.x == 0 && threadIdx.x < 64) {
        unsigned* bw = (unsigned*)(p.ws + W_BAR);
        for (int i = threadIdx.x; i < 4096; i += 64) __hip_atomic_store(bw + i, 0u, __ATOMIC_RELAXED, __HIP_MEMORY_SCOPE_AGENT);
        asm volatile("s_waitcnt vmcnt(0)" ::: "memory");
        __builtin_amdgcn_fence(__ATOMIC_RELEASE, "agent");
        asm volatile("s_waitcnt vmcnt(0)" ::: "memory");
    }
    grid.sync();
    const XcdBarrier xb = xcd_barrier_post((unsigned*)(p.ws + W_BAR), xst);
    phase_prep(p, (float*)shm);
    xcd_barrier(xb);
    { GemmD g{XN, (const bf16_t*)(p.ws + W_WINT), DM, DM, DM, TROWS / BM, NPROJ / BM, 0, 0, 1, 0, (int)blockIdx.x, (int)gridDim.x, 0, (TROWS / BM) * (NPROJ / BM), 0};
      EpiProj e{PROJ, (float*)(p.ws + W_DTRAW)};
      gemm_phase(lds, g, e); }
    xcd_barrier(xb);
    phase_elem(p, shm);
    xcd_barrier(xb);
    phase_ssd(p, shm);
    xcd_barrier(xb);
    { GemmD g{XN  , (const bf16_t*)(p.ws + W_WMIX), DM, 512, 512, TROWS / BM, DM / BM, 2, 512, 1, 0, (int)blockIdx.x, (int)gridDim.x, 0, (TROWS / BM) * (DM / BM), 0};
      EpiMix e{PROJ, A2, p.pool_mix_b, p.pool_scale};
      gemm_phase(lds, g, e); }
    if (blockIdx.x >= 48) phase_ynorm(p, blockIdx.x - 48, gridDim.x - 48);
    xcd_barrier(xb);
#pragma unroll 1
    for (int stage = 0; stage < 3; ++stage) {
        const int bid = blockIdx.x;
        float* Fh = (float*)(p.ws + W_XACT);
        if (stage == 0) {
            GemmD g{A2, (const bf16_t*)(p.ws + W_WSP), 4096, 4096, 2048, 32, DM / BM, 0, 0, 2, 0, bid, 256, 0, 256, 0};
            EpiMerged e{PROJ, XN  };
            gemm_phase(lds, g, e);
        } else if (stage == 1 && bid < 96) {
            const int which = bid >= 48 ? 1 : 0;
            GemmD g{A2 + which * 2048, (const bf16_t*)(p.ws + W_WSP) + which * 2048, 4096, 4096, 2048, 6, DM / BM, 0, 0, 1, 32, bid - 48 * which, 48, 0, 48, 0};
            EpiHalf e{PROJ, Fh + (size_t)which * 1536 * DM, which};
            gemm_phase(lds, g, e);
        } else if (stage == 1 || bid < 144) {
            const bool tailp = (stage == 2 && bid >= 96);
            GemmD g{XN  , (const bf16_t*)(p.ws + W_WOUT), DM, DM, DM, tailp ? 6 : 32, DM / BM, 0, 0, 1, tailp ? 32 : 0,
                    stage == 1 ? bid - 96 : (tailp ? bid - 96 : bid), stage == 1 ? 160 : (tailp ? 48 : 96), (stage == 2 && !tailp) ? 160 : 0, stage == 1 ? 160 : (tailp ? 48 : 256), tailp ? 0 : 1};
            EpiOut e{p, (float*)(p.ws + W_RSS)};
            gemm_phase(lds, g, e);
        } else if (stage == 2) {
            phase_final(p, 0, 5120, bid - 144, 112);
        }
        xcd_barrier(xb);
        if (stage == 1) {
            const int tid = tid_opaque();
            for (int i = bid * 512 + tid; i < 1536 * DM / 8; i += 256 * 512) {
                const f32x4 a0 = __builtin_nontemporal_load((const f32x4*)(Fh + (size_t)i * 8)), a1 = __builtin_nontemporal_load((const f32x4*)(Fh + (size_t)i * 8 + 4)), b0 = __builtin_nontemporal_load((const f32x4*)(Fh + (size_t)1536 * DM + (size_t)i * 8)), b1 = __builtin_nontemporal_load((const f32x4*)(Fh + (size_t)1536 * DM + (size_t)i * 8 + 4));
                u32x4 w; w.x = pk2(a0[0] + b0[0], a0[1] + b0[1]); w.y = pk2(a0[2] + b0[2], a0[3] + b0[3]); w.z = pk2(a1[0] + b1[0], a1[1] + b1[1]); w.w = pk2(a1[2] + b1[2], a1[3] + b1[3]);
                *(u32x4*)(XN + (size_t)8192 * DM + (size_t)i * 8) = w; }
            xcd_barrier(xb);
        }
    }
    phase_final(p, 5120, TROWS, blockIdx.x, gridDim.x);
}

extern "C" void kernel_launch(void* const* d_in, const int* in_sizes, int n_in, void* d_out, int out_size, void* d_ws, size_t ws_size, hipStream_t stream) {
    static int grid_blocks = 0;
    if (!grid_blocks) {
        int dev = 0, cus = 0, per_cu = 0;
        hipGetDevice(&dev);
        hipDeviceGetAttribute(&cus, hipDeviceAttributeMultiprocessorCount, dev);
        hipFuncSetAttribute((const void*)fwd_megakernel, hipFuncAttributeMaxDynamicSharedMemorySize, LDS_BYTES);
        hipOccupancyMaxActiveBlocksPerMultiprocessor(&per_cu, fwd_megakernel, 512, LDS_BYTES);
        if (per_cu > 1) per_cu = 1;
        grid_blocks = cus * per_cu;
        grid_blocks &= ~7;
        if (grid_blocks != 256) { fprintf(stderr, "this kernel's static schedule needs exactly 256 resident workgroups (got %d)\n", grid_blocks); grid_blocks = -1; }
    }
    if (ws_size < W_END || grid_blocks <= 0) { fprintf(stderr, "workspace too small or no occupancy (%zu, %d)\n", ws_size, grid_blocks); return; }
    Params p{};
    const float** f = (const float**)&p;
    for (int i = 0; i < 21; ++i) f[i] = (const float*)d_in[i];
    p.out = (float*)d_out; p.ws = (unsigned char*)d_ws;
    void* args[] = {&p};
    hipError_t e = hipLaunchCooperativeKernel((void*)fwd_megakernel, dim3(grid_blocks), dim3(512), args, LDS_BYTES, stream);
    if (e != hipSuccess) fprintf(stderr, "cooperative launch failed: %s (grid %d)\n", hipGetErrorString(e), grid_blocks);
}
```

```cpp
#include <hip/hip_runtime.h>
#include <hip/hip_cooperative_groups.h>
#include <cstdio>
namespace cg = cooperative_groups;

#define LAS __attribute__((address_space(3)))
typedef unsigned short bf16_t;
typedef short bf16x8 __attribute__((ext_vector_type(8)));
typedef float f32x4 __attribute__((ext_vector_type(4)));
typedef unsigned u32x4 __attribute__((ext_vector_type(4)));
typedef unsigned u32x2 __attribute__((ext_vector_type(2)));

constexpr int DM = 2048;
constexpr int TP = 2176;
constexpr int PADR = 112;
constexpr int ROWS_P = 4 * TP;
constexpr int TROWS = ROWS_P + 1024;
constexpr int NPROJ = 13568;
constexpr int C_Z = 0, C_XBC = 2048, C_ZP = 5120, C_U = 7168, C_GS = 9216, C_GP = 11264, C_DT = 13312;
constexpr int CONVD = 3072;
constexpr float EPS = 1e-6f;
constexpr size_t O_YP = 0, O_YS = 16777216, O_CP = 18874368, O_SP = 18911232, O_PP = 19959808, O_CS = 20082688, O_SS = 21262336, O_PS = 54816768;
constexpr size_t W_XN = 0;
constexpr size_t W_WINT = 39845888;
constexpr size_t W_WSP = W_WINT + 55574528;
constexpr size_t W_WMIX = W_WSP + 16777216;
constexpr size_t W_WOUT = W_WMIX + 2097152;
constexpr size_t W_PROJ = W_WOUT + 8388608;
constexpr size_t W_DTRAW = W_PROJ + 263979008;
constexpr size_t W_A2 = W_DTRAW + 1245184;
constexpr size_t W_YSS = W_A2 + 79691776;
constexpr size_t W_RSS = W_YSS + 1245184;
constexpr size_t W_XACT = W_RSS + 1245184;
constexpr size_t W_AC = W_XACT + 59768832;
constexpr size_t W_BAR = W_AC + 1114112;
constexpr size_t W_DT = W_BAR + 16384;
constexpr size_t W_END = W_DT + 1245184;
constexpr int LDS_BYTES = 147456;

struct Params {
    const float *x_prompt, *x_sample, *state_conv, *state_ssm, *state_pool, *meta, *norm_w, *w_in, *conv_w, *conv_b, *dt_bias, *a_log, *d_skip,
        *ssd_norm_w, *w_proj_ssd, *pool_mix_w, *pool_mix_b, *pool_scale, *w_proj_pool, *w_out, *final_norm_w;
    float* out;
    unsigned char* ws;
};

__device__ __forceinline__ int tid_opaque() { int t = threadIdx.x; asm volatile("" : "+v"(t)); return t; }
__device__ __forceinline__ float bf2f(unsigned b) { return __uint_as_float(b << 16); }
__device__ __forceinline__ float bflo(unsigned w) { return __uint_as_float(w << 16); }
__device__ __forceinline__ float bfhi(unsigned w) { return __uint_as_float(w & 0xffff0000u); }
__device__ __forceinline__ unsigned pk2(float lo, float hi) { unsigned r; asm("v_cvt_pk_bf16_f32 %0, %1, %2" : "=v"(r) : "v"(lo), "v"(hi)); return r; }
__device__ __forceinline__ bf16_t f2bf(float f) { return (bf16_t)(pk2(f, 0.f) & 0xffffu); }
__device__ __forceinline__ float sigmoidf_(float x) { return __builtin_amdgcn_rcpf(1.0f + __expf(-x)); }
__device__ __forceinline__ float siluf_(float x) { return x * __builtin_amdgcn_rcpf(1.0f + __expf(-x)); }
__device__ __forceinline__ float softplusf_(float x) { return x > 20.f ? x : log1pf(__expf(x)); }
__device__ __forceinline__ const float* row_src(const Params& p, int r) {
    if (r < ROWS_P) { const int b = r / TP, t = r - b * TP;
        if (t < PADR) return nullptr;
        if (t < 128) return p.meta + (size_t)(t - PADR) * DM;
        return p.x_prompt + ((size_t)b * 2048 + (t - 128)) * DM; }
    return p.x_sample + (size_t)(r - ROWS_P) * DM;
}
__device__ __forceinline__ float* row_dst(const Params& p, int r) {
    if (r < ROWS_P) { const int b = r / TP, t = r - b * TP;
        if (t < 128) return nullptr;
        return p.out + O_YP + ((size_t)b * 2048 + (t - 128)) * DM; }
    return p.out + O_YS + (size_t)(r - ROWS_P) * DM;
}

constexpr int BM = 256, BK = 64, HALF = 128, HTB = HALF * BK * 2, NXCD = 8, WGM = 8;
__device__ __forceinline__ int lds_byte(int r, int c) { const int st = (r >> 4) * 2 + (c >> 5), rr = r & 15, cc = c & 31, ob = rr * 64 + cc * 2; return st * 1024 + (ob ^ (((ob >> 9) & 1) << 5)); }
__device__ __forceinline__ void stage_rc(int b, int& R, int& C) { const int st = b / 1024, sb = b % 1024, swz = sb ^ (((sb >> 9) & 1) << 5); R = (st >> 1) * 16 + swz / 64; C = (st & 1) * 32 + (swz % 64) / 2; }
__device__ __forceinline__ int perm32(int rho) { const int n = rho >> 4, i = rho & 15; return 8 * (i >> 2) + 4 * n + (i & 3); }
struct Unit { int pm, pn, sub; };
struct GemmD { const bf16_t* A; const bf16_t* Bt; int lda, ldb, K, nM, nN, a_kdiv, a_kstride, nsub, pm_off, vbid, vG, t0, tmax, linear; };
__device__ __forceinline__ bool unit_next(const GemmD& g, int i, Unit& u) {
    u.sub = g.nsub == 2 ? (i & 1) : 0; if (g.nsub == 2) i >>= 1;
    const int nwg = g.nM * g.nN; const long L = (long)g.t0 + (long)i * g.vG + g.vbid; if (L >= g.tmax) return false;
    if (g.linear) { u.pm = g.pm_off + (int)L / g.nN; u.pn = (int)L % g.nN; return true; }
    int wgid = (int)L; { const int q = nwg / NXCD, r = nwg % NXCD, xcd = wgid % NXCD, off = wgid / NXCD; wgid = (xcd < r ? xcd * (q + 1) : r * (q + 1) + (xcd - r) * q) + off; }
    const int nig = WGM * g.nN, gid = wgid / nig, fm = gid * WGM, gsz = (g.nM - fm) < WGM ? (g.nM - fm) : WGM;
    u.pm = g.pm_off + fm + ((wgid % nig) % gsz); u.pn = (wgid % nig) / gsz; return true;
}
__device__ __forceinline__ const char* unit_a(const GemmD& g, const Unit& u) { return (const char*)(g.A + (size_t)u.pm * BM * g.lda + (g.a_kdiv ? (u.pn / g.a_kdiv) * g.a_kstride : 0) + u.sub * g.K); }
__device__ __forceinline__ const char* unit_b(const GemmD& g, const Unit& u) { return (const char*)(g.Bt + (size_t)u.pn * BM * g.ldb + u.sub * g.K); }

template <class Epi>
__device__ __forceinline__ void gemm_phase(LAS unsigned char* lds, const GemmD g, const Epi& E) {
    const int tid = tid_opaque(), wid = __builtin_amdgcn_readfirstlane(tid >> 6), lane = tid & 63, wr = wid >> 2, wc = wid & 3, fr = lane & 15, fq = lane >> 4;
    const int K = g.K, nt = K / BK;
    unsigned voffA[2], voffB[2];
#pragma unroll
    for (int i = 0; i < 2; ++i) { int R, C; stage_rc(tid * 16 + i * 8192, R, C); const int Rb = (R & ~31) + perm32(R & 31);
        voffA[i] = (unsigned)(R * g.lda + C) * 2u; voffB[i] = (unsigned)(Rb * g.ldb + C) * 2u; }
    const size_t kstep = (size_t)(BK * 2);
    const size_t hstepA = (size_t)HALF * g.lda * 2, hstepB = (size_t)HALF * g.ldb * 2;
    const unsigned ldsw = (unsigned)wid * 1024u;
    const int aoff = lds_byte(wr * 64 + fr, fq * 8), boff = lds_byte(wc * 32 + fr, fq * 8);
#define PG8_SA(b, h) (((b) * 2 + (h)) * HTB)
#define PG8_SB(b, h) ((4 + (b) * 2 + (h)) * HTB)
#define PG8_STAGE(bufoff, gbase, voff) do { _Pragma("unroll") for (int _i = 0; _i < 2; ++_i) \
        __builtin_amdgcn_global_load_lds((const unsigned*)((const char*)(gbase) + (voff)[_i]), (LAS unsigned*)(lds + (bufoff) + ldsw + _i * 8192), 16, 0, 0); } while (0)
#define PG8_LDA(dst, b, h) do { _Pragma("unroll") for (int m = 0; m < 4; ++m) _Pragma("unroll") for (int k = 0; k < 2; ++k) dst[m][k] = *(const LAS bf16x8*)(lds + PG8_SA(b, h) + aoff + m * 2048 + k * 1024); } while (0)
#define PG8_LDB(dst, b, h) do { _Pragma("unroll") for (int n = 0; n < 2; ++n) _Pragma("unroll") for (int k = 0; k < 2; ++k) dst[n][k] = *(const LAS bf16x8*)(lds + PG8_SB(b, h) + boff + n * 2048 + k * 1024); } while (0)
#define PG8_MMA(ai, bj, At, Bt) do { __builtin_amdgcn_s_setprio(1); _Pragma("unroll") for (int m = 0; m < 4; ++m) _Pragma("unroll") for (int n = 0; n < 2; ++n) _Pragma("unroll") for (int k = 0; k < 2; ++k) \
        acc[ai][bj][m][n] = __builtin_amdgcn_mfma_f32_16x16x32_bf16(Bt[n][k], At[m][k], acc[ai][bj][m][n], 0, 0, 0); __builtin_amdgcn_s_setprio(0); } while (0)
#define PG8_WAIT_V(n) asm volatile("s_waitcnt vmcnt(" #n ")" ::: "memory")
#define PG8_WAIT_L(n) asm volatile("s_waitcnt lgkmcnt(" #n ")" ::: "memory")
#define PG8_BAR __builtin_amdgcn_s_barrier()
#define PG8_SCHED __builtin_amdgcn_sched_barrier(0)
    Unit cur, nxt; int ui = 0;
    if (!unit_next(g, 0, cur)) return;
    f32x4 acc[2][2][4][2];
#pragma unroll
    for (int a = 0; a < 2; ++a)
#pragma unroll
        for (int b = 0; b < 2; ++b)
#pragma unroll
            for (int m = 0; m < 4; ++m)
#pragma unroll
                for (int n = 0; n < 2; ++n) acc[a][b][m][n] = (f32x4){0.f, 0.f, 0.f, 0.f};
    bf16x8 At[4][2], B0[2][2], B1[2][2];
    const char* cA = unit_a(g, cur); const char* cB = unit_b(g, cur);
    PG8_STAGE(PG8_SB(0, 0), cB, voffB); PG8_STAGE(PG8_SA(0, 0), cA, voffA); PG8_STAGE(PG8_SB(0, 1), cB + hstepB, voffB); PG8_STAGE(PG8_SA(0, 1), cA + hstepA, voffA);
    if (wr == 1) PG8_BAR;
    PG8_WAIT_V(4); PG8_BAR;
    PG8_STAGE(PG8_SB(1, 0), cB + kstep, voffB); PG8_STAGE(PG8_SA(1, 0), cA + kstep, voffA); PG8_STAGE(PG8_SB(1, 1), cB + hstepB + kstep, voffB);
    PG8_WAIT_V(6); PG8_BAR;
    for (;;) {
        const bool has_next = unit_next(g, ui + 1, nxt);
        const char* nA = has_next ? unit_a(g, nxt) : cA; const char* nB = has_next ? unit_b(g, nxt) : cB;
#define PG8_KITER(t) do { \
            const bool last = ((t) == nt - 2); \
            const char* a1 = cA + (size_t)((t) + 1) * kstep; \
            const char* a2 = last ? nA : cA + (size_t)((t) + 2) * kstep; const char* b2 = last ? nB : cB + (size_t)((t) + 2) * kstep; \
            const char* a3 = a2 + kstep; const char* b3 = b2 + kstep; \
            PG8_LDB(B0, 0, 0); PG8_SCHED; PG8_LDA(At, 0, 0); PG8_STAGE(PG8_SA(1, 1), a1 + hstepA, voffA); \
            PG8_WAIT_L(8); PG8_BAR; PG8_WAIT_L(0); PG8_MMA(0, 0, At, B0); PG8_BAR; PG8_SCHED; \
            PG8_LDB(B1, 0, 1); PG8_STAGE(PG8_SB(0, 0), b2, voffB); \
            PG8_BAR; PG8_WAIT_L(0); PG8_MMA(0, 1, At, B1); PG8_BAR; \
            PG8_LDA(At, 0, 1); PG8_STAGE(PG8_SA(0, 0), a2, voffA); \
            PG8_BAR; PG8_WAIT_L(0); PG8_MMA(1, 0, At, B0); PG8_BAR; PG8_SCHED; \
            PG8_STAGE(PG8_SB(0, 1), b2 + hstepB, voffB); \
            PG8_WAIT_V(6); PG8_BAR; PG8_MMA(1, 1, At, B1); PG8_BAR; \
            PG8_LDB(B0, 1, 0); PG8_SCHED; PG8_LDA(At, 1, 0); PG8_STAGE(PG8_SA(0, 1), a2 + hstepA, voffA); \
            PG8_WAIT_L(8); PG8_BAR; PG8_WAIT_L(0); PG8_MMA(0, 0, At, B0); PG8_BAR; PG8_SCHED; \
            PG8_LDB(B1, 1, 1); PG8_STAGE(PG8_SB(1, 0), b3, voffB); \
            PG8_BAR; PG8_WAIT_L(0); PG8_MMA(0, 1, At, B1); PG8_BAR; \
            PG8_LDA(At, 1, 1); PG8_STAGE(PG8_SA(1, 0), a3, voffA); \
            PG8_BAR; PG8_WAIT_L(0); PG8_MMA(1, 0, At, B0); PG8_BAR; PG8_SCHED; \
            PG8_STAGE(PG8_SB(1, 1), b3 + hstepB, voffB); \
            PG8_WAIT_V(6); PG8_BAR; PG8_MMA(1, 1, At, B1); PG8_BAR; } while (0)
        for (int t = 0; t < nt; t += 2) PG8_KITER(t);
#undef PG8_KITER
        bool keep = false;
        if constexpr (Epi::MID) { if (cur.sub == 0) { E.mid(acc, cur, wr, wc, fr, fq); keep = true; } else E(acc, cur, wr, wc, fr, fq); }
        else E(acc, cur, wr, wc, fr, fq);
        if (!has_next) break;
        cur = nxt; cA = nA; cB = nB; ++ui;
        if (keep) continue;
#pragma unroll
        for (int a = 0; a < 2; ++a)
#pragma unroll
            for (int b = 0; b < 2; ++b)
#pragma unroll
                for (int m = 0; m < 4; ++m)
#pragma unroll
                    for (int n = 0; n < 2; ++n) acc[a][b][m][n] = (f32x4){0.f, 0.f, 0.f, 0.f};
    }
    PG8_WAIT_V(0);
    if (wr == 0) PG8_BAR;
    PG8_BAR;
#undef PG8_SA
#undef PG8_SB
#undef PG8_STAGE
#undef PG8_LDA
#undef PG8_LDB
#undef PG8_MMA
#undef PG8_WAIT_V
#undef PG8_WAIT_L
#undef PG8_BAR
#undef PG8_SCHED
}

struct EpiProj {
    static constexpr bool MID = false;
    bf16_t* proj; float* dtraw;
    __device__ __forceinline__ void mid(f32x4 (&)[2][2][4][2], const Unit&, int, int, int, int) const {}
    __device__ __forceinline__ void operator()(const f32x4 (&acc)[2][2][4][2], const Unit& u, int wr, int wc, int fr, int fq) const {
        const int row0 = u.pm * BM + wr * 64 + fr, col0 = u.pn * BM + wc * 32 + 8 * fq;
        const bool sig = (u.pn >= 36 && u.pn < 52), isdt = (u.pn == 52);
#pragma unroll
        for (int ai = 0; ai < 2; ++ai)
#pragma unroll
            for (int m = 0; m < 4; ++m) { const int row = row0 + ai * HALF + m * 16;
#pragma unroll
                for (int bj = 0; bj < 2; ++bj) { const f32x4 v0 = acc[ai][bj][m][0], v1 = acc[ai][bj][m][1]; const int col = col0 + bj * HALF;
                    if (sig) {
                        const int c = (col - C_GS) >> 1;
                        float ra[4], gp[4];
#pragma unroll
                        for (int j = 0; j < 4; ++j) { const float ea = __expf(-fminf(fmaxf(v0[j], -30.f), 30.f)), eb = __expf(-fminf(fmaxf(v1[j], -30.f), 30.f)); gp[j] = __builtin_amdgcn_rcpf(1.0f + eb); ra[j] = (1.0f + eb) * __builtin_amdgcn_rcpf(1.0f + ea); }
                        u32x2 wr_, wg; wr_.x = pk2(ra[0], ra[1]); wr_.y = pk2(ra[2], ra[3]); wg.x = pk2(gp[0], gp[1]); wg.y = pk2(gp[2], gp[3]);
                        *(u32x2*)(proj + (size_t)row * NPROJ + C_GS + c) = wr_;
                        *(u32x2*)(proj + (size_t)row * NPROJ + C_GP + c) = wg;
                    } else {
                        u32x4 w; w.x = pk2(v0[0], v0[1]); w.y = pk2(v0[2], v0[3]); w.z = pk2(v1[0], v1[1]); w.w = pk2(v1[2], v1[3]);
                        *(u32x4*)(proj + (size_t)row * NPROJ + col) = w;
                        if (isdt && col < C_DT + 32) { float* d = dtraw + (size_t)row * 32 + (col - C_DT); *(f32x4*)d = v0; *(f32x4*)(d + 4) = v1; } } } }
    }
};
struct EpiMix {
    static constexpr bool MID = false;
    const bf16_t* proj; bf16_t* a2; const float* bias; const float* scale;
    __device__ __forceinline__ void mid(f32x4 (&)[2][2][4][2], const Unit&, int, int, int, int) const {}
    __device__ __forceinline__ void operator()(const f32x4 (&acc)[2][2][4][2], const Unit& u, int wr, int wc, int fr, int fq) const {
        const int row0 = u.pm * BM + wr * 64 + fr, col0 = u.pn * BM + wc * 32 + 8 * fq;
#pragma unroll
        for (int bj = 0; bj < 2; ++bj) { const int col = col0 + bj * HALF;
            const f32x4 b0 = *(const f32x4*)(bias + col), b1 = *(const f32x4*)(bias + col + 4), s0 = *(const f32x4*)(scale + col), s1 = *(const f32x4*)(scale + col + 4);
#pragma unroll
            for (int ai = 0; ai < 2; ++ai)
#pragma unroll
                for (int m = 0; m < 4; ++m) { const int row = row0 + ai * HALF + m * 16;
                    const u32x4 z = __builtin_nontemporal_load((const u32x4*)(proj + (size_t)row * NPROJ + C_ZP + col));
                    f32x4 v0 = (acc[ai][bj][m][0] + b0) * s0, v1 = (acc[ai][bj][m][1] + b1) * s1;
                    v0[0] *= siluf_(bflo(z.x)); v0[1] *= siluf_(bfhi(z.x)); v0[2] *= siluf_(bflo(z.y)); v0[3] *= siluf_(bfhi(z.y));
                    v1[0] *= siluf_(bflo(z.z)); v1[1] *= siluf_(bfhi(z.z)); v1[2] *= siluf_(bflo(z.w)); v1[3] *= siluf_(bfhi(z.w));
                    u32x4 w; w.x = pk2(v0[0], v0[1]); w.y = pk2(v0[2], v0[3]); w.z = pk2(v1[0], v1[1]); w.w = pk2(v1[2], v1[3]);
                    *(u32x4*)(a2 + (size_t)row * 4096 + 2048 + col) = w; } }
    }
};
struct EpiMerged {
    static constexpr bool MID = true;
    const bf16_t* proj; bf16_t* merged;
    __device__ __forceinline__ void mid(f32x4 (&acc)[2][2][4][2], const Unit& u, int wr, int wc, int fr, int fq) const {
        const int row0 = u.pm * BM + wr * 64 + fr, col0 = u.pn * BM + wc * 32 + 8 * fq;
        u32x4 rv[2][4][2];
#pragma unroll
        for (int ai = 0; ai < 2; ++ai)
#pragma unroll
            for (int m = 0; m < 4; ++m) { const bf16_t* rp = proj + (size_t)(row0 + ai * HALF + m * 16) * NPROJ + C_GS + col0; rv[ai][m][0] = __builtin_nontemporal_load((const u32x4*)(rp)); rv[ai][m][1] = __builtin_nontemporal_load((const u32x4*)(rp + HALF)); }
#pragma unroll
        for (int ai = 0; ai < 2; ++ai)
#pragma unroll
            for (int m = 0; m < 4; ++m)
#pragma unroll
                for (int bj = 0; bj < 2; ++bj) { const u32x4 r = rv[ai][m][bj];
                    acc[ai][bj][m][0] *= (f32x4){bflo(r.x), bfhi(r.x), bflo(r.y), bfhi(r.y)}; acc[ai][bj][m][1] *= (f32x4){bflo(r.z), bfhi(r.z), bflo(r.w), bfhi(r.w)}; }
    }
    __device__ __forceinline__ void operator()(const f32x4 (&acc)[2][2][4][2], const Unit& u, int wr, int wc, int fr, int fq) const {
        const int row0 = u.pm * BM + wr * 64 + fr, col0 = u.pn * BM + wc * 32 + 8 * fq;
#pragma unroll
        for (int ai = 0; ai < 2; ++ai)
#pragma unroll
            for (int m = 0; m < 4; ++m) { const int row = row0 + ai * HALF + m * 16;
#pragma unroll
                for (int bj = 0; bj < 2; ++bj) { const int col = col0 + bj * HALF;
                    const u32x4 gp = *(const u32x4*)(proj + (size_t)row * NPROJ + C_GP + col);
                    const f32x4 v0 = acc[ai][bj][m][0], v1 = acc[ai][bj][m][1];
                    u32x4 w; w.x = pk2(v0[0] * bflo(gp.x), v0[1] * bfhi(gp.x)); w.y = pk2(v0[2] * bflo(gp.y), v0[3] * bfhi(gp.y));
                    w.z = pk2(v1[0] * bflo(gp.z), v1[1] * bfhi(gp.z)); w.w = pk2(v1[2] * bflo(gp.w), v1[3] * bfhi(gp.w));
                    *(u32x4*)(merged + (size_t)row * DM + col) = w; } }
    }
};
struct EpiHalf {
    static constexpr bool MID = false;
    const bf16_t* proj; float* F; int which;
    __device__ __forceinline__ void mid(f32x4 (&)[2][2][4][2], const Unit&, int, int, int, int) const {}
    __device__ __forceinline__ void operator()(const f32x4 (&acc)[2][2][4][2], const Unit& u, int wr, int wc, int fr, int fq) const {
        const int row0 = u.pm * BM + wr * 64 + fr, col0 = u.pn * BM + wc * 32 + 8 * fq;
#pragma unroll
        for (int ai = 0; ai < 2; ++ai)
#pragma unroll
            for (int m = 0; m < 4; ++m) { const int row = row0 + ai * HALF + m * 16;
#pragma unroll
                for (int bj = 0; bj < 2; ++bj) { const int col = col0 + bj * HALF;
                    const u32x4 gp = *(const u32x4*)(proj + (size_t)row * NPROJ + C_GP + col);
                    f32x4 f0 = (f32x4){bflo(gp.x), bfhi(gp.x), bflo(gp.y), bfhi(gp.y)}, f1 = (f32x4){bflo(gp.z), bfhi(gp.z), bflo(gp.w), bfhi(gp.w)};
                    if (which == 0) { const u32x4 r = *(const u32x4*)(proj + (size_t)row * NPROJ + C_GS + col);
                        f0 *= (f32x4){bflo(r.x), bfhi(r.x), bflo(r.y), bfhi(r.y)}; f1 *= (f32x4){bflo(r.z), bfhi(r.z), bflo(r.w), bfhi(r.w)}; }
                    float* d = F + (size_t)(row - 8192) * DM + col;
                    *(f32x4*)d = acc[ai][bj][m][0] * f0; *(f32x4*)(d + 4) = acc[ai][bj][m][1] * f1; } }
    }
};
struct EpiOut {
    static constexpr bool MID = false;
    Params p; float* rss;
    __device__ __forceinline__ void mid(f32x4 (&)[2][2][4][2], const Unit&, int, int, int, int) const {}
    __device__ __forceinline__ void operator()(const f32x4 (&acc)[2][2][4][2], const Unit& u, int wr, int wc, int fr, int fq) const {
        const int row0 = u.pm * BM + wr * 64 + fr, col0 = u.pn * BM + wc * 32 + 8 * fq;
#pragma unroll
        for (int ai = 0; ai < 2; ++ai)
#pragma unroll
            for (int m = 0; m < 4; ++m) { const int row = row0 + ai * HALF + m * 16;
                const float* src = row_src(p, row); float* dst = row_dst(p, row); float ss = 0.f;
                if (dst) {
#pragma unroll
                    for (int bj = 0; bj < 2; ++bj) { const int col = col0 + bj * HALF;
                        const f32x4 h0 = __builtin_nontemporal_load((const f32x4*)(src + col)), h1 = __builtin_nontemporal_load((const f32x4*)(src + col + 4));
                        const f32x4 v0 = acc[ai][bj][m][0] + h0, v1 = acc[ai][bj][m][1] + h1;
                        *(f32x4*)(dst + col) = v0; *(f32x4*)(dst + col + 4) = v1;
                        ss += v0[0] * v0[0] + v0[1] * v0[1] + v0[2] * v0[2] + v0[3] * v0[3] + v1[0] * v1[0] + v1[1] * v1[1] + v1[2] * v1[2] + v1[3] * v1[3]; } }
                ss += __shfl_xor(ss, 16); ss += __shfl_xor(ss, 32);
                if (fq == 0) rss[(size_t)row * 32 + u.pn * 4 + wc] = ss; }
    }
};

__device__ __forceinline__ int win_src_col(int n) {
    if (n < 5120) return n;
    if (n < C_GS) return n + 32;
    if (n < C_DT) { const int j = n - C_GS, k = j >> 3, wi = j & 7; return ((wi >> 2) ? 11296 : 9248) + 4 * k + (wi & 3); }
    if (n < C_DT + 32) return n - C_DT + 5120;
    return -1;
}
constexpr int TT_LD = 257;
struct TTile { const float* src; bf16_t* dst; int sld, dld, k0, n0, remap; };
__device__ __forceinline__ TTile tt_get(const Params& p, int it) {
    bf16_t* WINT = (bf16_t*)(p.ws + W_WINT); bf16_t* WSP = (bf16_t*)(p.ws + W_WSP); bf16_t* WMIX = (bf16_t*)(p.ws + W_WMIX); bf16_t* WOUT = (bf16_t*)(p.ws + W_WOUT);
    constexpr int NT_IN = 53 * 32, NT_SQ = 8 * 32;
    TTile t;
    if (it < NT_IN) { t = TTile{p.w_in, WINT, 13344, DM, (it & 31) * 64, (it >> 5) * 256, 1}; }
    else if (it < NT_IN + NT_SQ) { const int j = it - NT_IN; t = TTile{p.w_proj_ssd, WSP, DM, 4096, (j & 31) * 64, (j >> 5) * 256, 0}; }
    else if (it < NT_IN + 2 * NT_SQ) { const int j = it - NT_IN - NT_SQ; t = TTile{p.w_proj_pool, WSP + 2048, DM, 4096, (j & 31) * 64, (j >> 5) * 256, 0}; }
    else if (it < NT_IN + 3 * NT_SQ) { const int j = it - NT_IN - 2 * NT_SQ; t = TTile{p.w_out, WOUT, DM, DM, (j & 31) * 64, (j >> 5) * 256, 0}; }
    else { const int j = it - NT_IN - 3 * NT_SQ, gq = j >> 4, r = j & 15; t = TTile{p.pool_mix_w + (size_t)gq * 512 * 512, WMIX + (size_t)gq * 512 * 512, 512, 512, (r & 7) * 64, (r >> 3) * 256, 0}; }
    return t;
}
constexpr int TT_TOTAL = 53 * 32 + 3 * 8 * 32 + 64;
__device__ __forceinline__ void tt_load(const TTile& t, int tid, f32x4 (&v)[8]) {
    const int c4 = tid & 63, kb = tid >> 6; const int n = t.n0 + 4 * c4; const int sc = t.remap ? win_src_col(n) : n;
#pragma unroll
    for (int ps = 0; ps < 8; ++ps) { const int k = ps * 8 + kb; v[ps] = sc >= 0 ? __builtin_nontemporal_load((const f32x4*)(t.src + (size_t)(t.k0 + k) * t.sld + sc)) : (f32x4){0.f, 0.f, 0.f, 0.f}; }
}
__device__ __forceinline__ void phase_prep(const Params& p, float* tile) {
    const int tid = tid_opaque(), wid = tid >> 6, lane = tid & 63;
    bf16_t* XN = (bf16_t*)(p.ws + W_XN);
    for (int r = blockIdx.x * 8 + wid; r < TROWS; r += gridDim.x * 8) {
        const float* src = row_src(p, r); bf16_t* dst = XN + (size_t)r * DM;
        if (!src) {
#pragma unroll
            for (int i = 0; i < 4; ++i) *(u32x4*)(dst + (lane + 64 * i) * 8) = (u32x4){0u, 0u, 0u, 0u};
        } else {
            f32x4 v[8]; float ss = 0.f;
#pragma unroll
            for (int i = 0; i < 8; ++i) { v[i] = __builtin_nontemporal_load((const f32x4*)src + lane + 64 * i); ss += v[i][0] * v[i][0] + v[i][1] * v[i][1] + v[i][2] * v[i][2] + v[i][3] * v[i][3]; }
#pragma unroll
            for (int o = 32; o >= 1; o >>= 1) ss += __shfl_xor(ss, o);
            const float rs = rsqrtf(ss * (1.0f / DM) + EPS);
#pragma unroll
            for (int i = 0; i < 8; ++i) { const f32x4 w = ((const f32x4*)p.norm_w)[lane + 64 * i];
                u32x2 o; o.x = pk2(v[i][0] * rs * w[0], v[i][1] * rs * w[1]); o.y = pk2(v[i][2] * rs * w[2], v[i][3] * rs * w[3]);
                *(u32x2*)(dst + (lane + 64 * i) * 4) = o; }
        }
    }
    int it = blockIdx.x;
    if (it < TT_TOTAL) {
        TTile cur = tt_get(p, it); f32x4 v[8]; tt_load(cur, tid, v);
        for (;;) {
            { const int c4 = tid & 63, kb = tid >> 6;
#pragma unroll
                for (int ps = 0; ps < 8; ++ps) { float* d = tile + (ps * 8 + kb) * TT_LD + 4 * c4; d[0] = v[ps][0]; d[1] = v[ps][1]; d[2] = v[ps][2]; d[3] = v[ps][3]; } }
            __syncthreads();
            const int nit = it + gridDim.x; const bool more = nit < TT_TOTAL;
            const TTile nxt = tt_get(p, more ? nit : it);
            if (more) tt_load(nxt, tid, v);
            { const int kg = tid & 7, nb = tid >> 3;
#pragma unroll
                for (int i = 0; i < 4; ++i) { const int n = nb + 64 * i; float x[8];
#pragma unroll
                    for (int j = 0; j < 8; ++j) x[j] = tile[(kg * 8 + j) * TT_LD + n];
                    u32x4 w; w.x = pk2(x[0], x[1]); w.y = pk2(x[2], x[3]); w.z = pk2(x[4], x[5]); w.w = pk2(x[6], x[7]);
                    *(u32x4*)(cur.dst + (size_t)(cur.n0 + n) * cur.dld + cur.k0 + kg * 8) = w; } }
            __syncthreads();
            if (!more) break;
            cur = nxt; it = nit;
        }
    }
}

__device__ __forceinline__ void pool_prompt(const Params& p, unsigned char* smem, int b, int rt, int g) {
    const int tid = tid_opaque();
    bf16_t* tile = (bf16_t*)smem;
    const bf16_t* PROJ = (const bf16_t*)(p.ws + W_PROJ);
    bf16_t* POOLED = (bf16_t*)(p.ws + W_XN);
    const int r0 = b * TP + rt * 64;
#pragma unroll
    for (int v = tid; v < 79 * 64; v += 512) { const int k = v >> 6, cv = v & 63; int rr = r0 - 15 + k; rr = rr < 0 ? 0 : rr;
        *(u32x4*)(tile + k * 512 + cv * 8) = __builtin_nontemporal_load((const u32x4*)(PROJ + (size_t)rr * NPROJ + C_U + g * 512 + cv * 8)); }
    __syncthreads();
    const int w = 2 << g, c2 = tid & 255, hf = tid >> 8;
    const unsigned* tile32 = (const unsigned*)tile;
    float s0 = 0.f, s1 = 0.f;
    for (int k = 1; k < w; ++k) { const unsigned x = tile32[(15 + 32 * hf - k) * 256 + c2]; s0 += bflo(x); s1 += bfhi(x); }
#pragma unroll 8
    for (int i = 0; i < 32; ++i) {
        const int ri = 32 * hf + i, tseq = rt * 64 + ri; int cnt = tseq - PADR + 1; cnt = cnt > w ? w : cnt; cnt = cnt < 1 ? 1 : cnt;
        const unsigned cu = tile32[(15 + ri) * 256 + c2]; const float c0 = bflo(cu), c1 = bfhi(cu);
        s0 += c0; s1 += c1;
        const float inv = __builtin_amdgcn_rcpf((float)cnt);
        *(unsigned*)(POOLED + (size_t)(r0 + ri) * DM + g * 512 + 2 * c2) = pk2(s0 * inv - c0, s1 * inv - c1);
        const unsigned ou = tile32[(15 + ri - (w - 1)) * 256 + c2]; s0 -= bflo(ou); s1 -= bfhi(ou);
        if (tseq >= TP - 15) { float* d = p.out + O_PP + ((size_t)b * 15 + (tseq - (TP - 15))) * DM + g * 512 + 2 * c2; d[0] = c0; d[1] = c1; }
    }
    __syncthreads();
}
__device__ __forceinline__ void pool_sample(const Params& p, int s, int g) {
    const int col = g * 512 + tid_opaque(), w = 2 << g;
    const bf16_t* PROJ = (const bf16_t*)(p.ws + W_PROJ);
    bf16_t* POOLED = (bf16_t*)(p.ws + W_XN);
    float v[23];
#pragma unroll
    for (int j = 0; j < 15; ++j) v[j] = __builtin_nontemporal_load(p.state_pool + ((size_t)s * 15 + j) * DM + col);
#pragma unroll
    for (int t = 0; t < 8; ++t) v[15 + t] = bf2f(PROJ[(size_t)(ROWS_P + s * 8 + t) * NPROJ + C_U + col]);
    const float inv = 1.0f / (float)w;
#pragma unroll
    for (int t = 0; t < 8; ++t) { float sum = 0.f;
#pragma unroll
        for (int k = 0; k < 16; ++k) sum += (k < w) ? v[15 + t - k] : 0.f;
        POOLED[(size_t)(ROWS_P + s * 8 + t) * DM + col] = f2bf(sum * inv - v[15 + t]); }
#pragma unroll
    for (int j = 0; j < 15; ++j) p.out[O_PS + ((size_t)s * 15 + j) * DM + col] = v[j + 8];
}

__device__ __forceinline__ void phase_conv(const Params& p) {
    const bf16_t* PROJ = (const bf16_t*)(p.ws + W_PROJ);
    bf16_t* XACT = (bf16_t*)(p.ws + W_XACT);
    constexpr int NRUN = TROWS / 8, NCG = CONVD / 8, NRUN_P = ROWS_P / 8;
    const int tid = tid_opaque();
    struct Raw { u32x4 L[11]; };
    auto load_raw = [&](int item, Raw& r) {
        const int run = item / NCG, cc = (item - run * NCG) * 8, r0 = run * 8;
        const bool smp = run >= NRUN_P;
#pragma unroll
        for (int k = 0; k < 11; ++k) { int rr = r0 - 3 + k; rr = (rr < 0 || (smp && k < 3)) ? r0 : rr; r.L[k] = __builtin_nontemporal_load((const u32x4*)(PROJ + (size_t)rr * NPROJ + C_XBC + cc)); }
    };
    auto compute = [&](int item, const Raw& r) {
        const int run = item / NCG, cc = (item - run * NCG) * 8, r0 = run * 8;
        const bool smp = run >= NRUN_P; const int s = run - NRUN_P;
        const bool zero0 = (!smp && r0 < 3);
        float hv[3][8];
#pragma unroll
        for (int k = 0; k < 3; ++k) {
            if (smp) { const f32x4 a = __builtin_nontemporal_load((const f32x4*)(p.state_conv + ((size_t)s * 3 + k) * CONVD + cc)), b = __builtin_nontemporal_load((const f32x4*)(p.state_conv + ((size_t)s * 3 + k) * CONVD + cc + 4));
                hv[k][0] = a[0]; hv[k][1] = a[1]; hv[k][2] = a[2]; hv[k][3] = a[3]; hv[k][4] = b[0]; hv[k][5] = b[1]; hv[k][6] = b[2]; hv[k][7] = b[3]; }
            else { const u32x4 L = r.L[k];
                hv[k][0] = bflo(L.x); hv[k][1] = bfhi(L.x); hv[k][2] = bflo(L.y); hv[k][3] = bfhi(L.y); hv[k][4] = bflo(L.z); hv[k][5] = bfhi(L.z); hv[k][6] = bflo(L.w); hv[k][7] = bfhi(L.w);
                if (zero0) {
#pragma unroll
                    for (int j = 0; j < 8; ++j) hv[k][j] = 0.f; } }
        }
        float w[4][8], bb[8];
#pragma unroll
        for (int k = 0; k < 4; ++k) { const f32x4 a = *(const f32x4*)(p.conv_w + k * CONVD + cc), b = *(const f32x4*)(p.conv_w + k * CONVD + cc + 4);
            w[k][0] = a[0]; w[k][1] = a[1]; w[k][2] = a[2]; w[k][3] = a[3]; w[k][4] = b[0]; w[k][5] = b[1]; w[k][6] = b[2]; w[k][7] = b[3]; }
        { const f32x4 a = *(const f32x4*)(p.conv_b + cc), b = *(const f32x4*)(p.conv_b + cc + 4); bb[0] = a[0]; bb[1] = a[1]; bb[2] = a[2]; bb[3] = a[3]; bb[4] = b[0]; bb[5] = b[1]; bb[6] = b[2]; bb[7] = b[3]; }
#pragma unroll
        for (int i = 0; i < 8; ++i) { float o[8];
#pragma unroll
            for (int j = 0; j < 8; ++j) o[j] = bb[j];
#pragma unroll
            for (int k = 0; k < 4; ++k) { const int rk = i + k;
                float x[8];
                if (rk < 3) {
#pragma unroll
                    for (int j = 0; j < 8; ++j) x[j] = hv[rk][j];
                } else { const u32x4 L = r.L[rk]; x[0] = bflo(L.x); x[1] = bfhi(L.x); x[2] = bflo(L.y); x[3] = bfhi(L.y); x[4] = bflo(L.z); x[5] = bfhi(L.z); x[6] = bflo(L.w); x[7] = bfhi(L.w); }
#pragma unroll
                for (int j = 0; j < 8; ++j) o[j] += x[j] * w[k][j]; }
#pragma unroll
            for (int j = 0; j < 8; ++j) o[j] = siluf_(o[j]);
            u32x4 q; q.x = pk2(o[0], o[1]); q.y = pk2(o[2], o[3]); q.z = pk2(o[4], o[5]); q.w = pk2(o[6], o[7]);
            *(u32x4*)(XACT + (size_t)(r0 + i) * CONVD + cc) = q; }
        float* cst = nullptr;
        if (smp) cst = p.out + O_CS + (size_t)s * 3 * CONVD + cc;
        else if ((run % (TP / 8)) == TP / 8 - 1) cst = p.out + O_CP + (size_t)(run / (TP / 8)) * 3 * CONVD + cc;
        if (cst) {
#pragma unroll
            for (int j = 0; j < 3; ++j) { const u32x4 L = r.L[8 + j];
                *(f32x4*)(cst + j * CONVD) = (f32x4){bflo(L.x), bfhi(L.x), bflo(L.y), bfhi(L.y)}; *(f32x4*)(cst + j * CONVD + 4) = (f32x4){bflo(L.z), bfhi(L.z), bflo(L.w), bfhi(L.w)}; } }
    };
    {
        const int NIT = NRUN * NCG, stride = gridDim.x * 512;
        int item = blockIdx.x * 512 + tid;
        Raw ra, rb;
        if (item < NIT) load_raw(item, ra);
        while (item < NIT) {
            int nxt = item + stride;
            if (nxt < NIT) load_raw(nxt, rb);
            compute(item, ra);
            item = nxt;
            if (item < NIT) { nxt = item + stride; if (nxt < NIT) load_raw(nxt, ra); compute(item, rb); item = nxt; }
        }
    }
    const float* DTR = (const float*)(p.ws + W_DTRAW); float* DT = (float*)(p.ws + W_DT); float* AC = (float*)(p.ws + W_AC);
    { const int wid = tid >> 6, lane = tid & 63;
      for (int it = blockIdx.x * 8 + wid; it < 68 * 32; it += gridDim.x * 8) { const int ch = it >> 5, h = it & 31;
          const size_t r0 = (size_t)ch * 128 + 2 * lane; const int tseq = (ch % 17) * 128 + 2 * lane;
          float d0 = softplusf_(DTR[r0 * 32 + h] + p.dt_bias[h]), d1 = softplusf_(DTR[(r0 + 1) * 32 + h] + p.dt_bias[h]);
          if (tseq < PADR) d0 = 0.f; if (tseq + 1 < PADR) d1 = 0.f;
          const float a = -__expf(p.a_log[h]), v0 = d0 * a, v1 = d1 * a, s = v0 + v1; float incl = s;
#pragma unroll
          for (int o = 1; o < 64; o <<= 1) { const float nb = __shfl_up(incl, o); if (lane >= o) incl += nb; }
          const float excl = incl - s;
          DT[r0 * 32 + h] = d0; DT[(r0 + 1) * 32 + h] = d1; AC[r0 * 32 + h] = excl + v0; AC[(r0 + 1) * 32 + h] = excl + s; } }
    for (int e = ROWS_P * 32 + blockIdx.x * 512 + tid; e < TROWS * 32; e += gridDim.x * 512) DT[e] = softplusf_(DTR[e] + p.dt_bias[e & 31]);
}

typedef short s16x4 __attribute__((ext_vector_type(4)));
constexpr int XROW = 72, LROW = 136;
__device__ __forceinline__ u32x2 tr4(LAS bf16_t* img, int stride, int R0, int col0, int fr) {
    const s16x4 v = __builtin_amdgcn_ds_read_tr16_b64_v4i16((LAS s16x4*)(img + (R0 + (fr >> 2)) * stride + col0 + 4 * (fr & 3)));
    return __builtin_bit_cast(u32x2, v);
}
__device__ __forceinline__ void ssd_prompt(const Params& p, LAS unsigned char* lds, int b, int h) {
    const int tid = tid_opaque(), wid = __builtin_amdgcn_readfirstlane(tid >> 6), lane = tid & 63, fr = lane & 15, fq = lane >> 4;
    const int g = h >> 3;
    LAS bf16_t* sX = (LAS bf16_t*)(lds);
    LAS bf16_t* sB = (LAS bf16_t*)(lds + 18432);
    LAS bf16_t* sC = (LAS bf16_t*)(lds + 53248);
    LAS bf16_t* sH = (LAS bf16_t*)(lds + 88064);
    LAS float* sDt = (LAS float*)(lds + 105472);
    LAS float* sAc = sDt + 128;
    LAS float* sW = sAc + 128;
    const bf16_t* PROJ = (const bf16_t*)(p.ws + W_PROJ);
    const bf16_t* XACT = (const bf16_t*)(p.ws + W_XACT);
    const float* DT = (const float*)(p.ws + W_DT);
    const float* AC = (const float*)(p.ws + W_AC);
    bf16_t* A2 = (bf16_t*)(p.ws + W_A2);
    float* YSS = (float*)(p.ws + W_YSS);
    const float Dh = p.d_skip[h];
    for (int i = tid; i < 64 * LROW / 2; i += 512) ((LAS unsigned*)sH)[i] = 0u;
    f32x4 hacc[4];
#pragma unroll
    for (int i = 0; i < 4; ++i) hacc[i] = (f32x4){0.f, 0.f, 0.f, 0.f};
    const int trow = 16 * wid + fr;
    u32x4 rx[2], rb[4], rc[4]; u32x2 rz[4]; float rd0 = 0.f, rd1 = 0.f, ra0 = 0.f, ra1 = 0.f;
#define SSD_ISSUE(cn) do { const size_t nb_ = (size_t)b * TP + (size_t)(cn) * 128; \
        _Pragma("unroll") for (int i = 0; i < 2; ++i) { const int v_ = tid + 512 * i; rx[i] = *(const u32x4*)(XACT + (nb_ + (v_ >> 3)) * CONVD + h * 64 + (v_ & 7) * 8); } \
        _Pragma("unroll") for (int i = 0; i < 4; ++i) { const int v_ = tid + 512 * i; const bf16_t* q_ = XACT + (nb_ + (v_ >> 4)) * CONVD + 2048 + g * 128 + (v_ & 15) * 8; rb[i] = *(const u32x4*)q_; rc[i] = *(const u32x4*)(q_ + 512); } \
        if (wid == 0) { rd0 = DT[(nb_ + 2 * lane) * 32 + h]; rd1 = DT[(nb_ + 2 * lane + 1) * 32 + h]; ra0 = AC[(nb_ + 2 * lane) * 32 + h]; ra1 = AC[(nb_ + 2 * lane + 1) * 32 + h]; } } while (0)
#define SSD_ISSUE_Z(cn) do { const bf16_t* q_ = PROJ + ((size_t)b * TP + (size_t)(cn) * 128 + trow) * NPROJ + C_Z + h * 64 + 4 * fq; \
        _Pragma("unroll") for (int pt = 0; pt < 4; ++pt) rz[pt] = *(const u32x2*)(q_ + 16 * pt); } while (0)
    SSD_ISSUE(0); SSD_ISSUE_Z(0);
    for (int c = 0; c < 17; ++c) {
        const int base = b * TP + c * 128;
        if (wid == 0) { const int t0 = 2 * lane; sDt[t0] = rd0; sDt[t0 + 1] = rd1; sAc[t0] = ra0; sAc[t0 + 1] = ra1; }
#pragma unroll
        for (int i = 0; i < 2; ++i) { const int v_ = tid + 512 * i; *(LAS u32x4*)(sX + (v_ >> 3) * XROW + (v_ & 7) * 8) = rx[i]; }
#pragma unroll
        for (int i = 0; i < 4; ++i) { const int v_ = tid + 512 * i; *(LAS u32x4*)(sB + (v_ >> 4) * LROW + (v_ & 15) * 8) = rb[i]; *(LAS u32x4*)(sC + (v_ >> 4) * LROW + (v_ & 15) * 8) = rc[i]; }
        __syncthreads();
        const int cn = c < 16 ? c + 1 : 16;
        SSD_ISSUE(cn);
        if (tid < 128) sW[tid] = __expf(sAc[127] - sAc[tid]) * sDt[tid];
        const float act = sAc[trow];
        bf16x8 cf[4];
#pragma unroll
        for (int kk = 0; kk < 4; ++kk) cf[kk] = *(const LAS bf16x8*)(sC + trow * LROW + 32 * kk + 8 * fq);
        f32x4 d[8];
#pragma unroll
        for (int st = 0; st < 8; ++st) d[st] = (f32x4){0.f, 0.f, 0.f, 0.f};
#pragma unroll
        for (int kk = 0; kk < 4; ++kk) {
            bf16x8 bfr[8];
#pragma unroll
            for (int st = 0; st < 8; ++st) bfr[st] = *(const LAS bf16x8*)(sB + (16 * st + fr) * LROW + 32 * kk + 8 * fq);
#pragma unroll
            for (int st = 0; st < 8; ++st) d[st] = __builtin_amdgcn_mfma_f32_16x16x32_bf16(bfr[st], cf[kk], d[st], 0, 0, 0);
        }
        bf16x8 gfrag[4];
        {
#pragma unroll
            for (int kb = 0; kb < 4; ++kb) {
                f32x4 acs[2], dts[2];
#pragma unroll
                for (int hf = 0; hf < 2; ++hf) { acs[hf] = *(const LAS f32x4*)(sAc + 16 * (2 * kb + hf) + 4 * fq); dts[hf] = *(const LAS f32x4*)(sDt + 16 * (2 * kb + hf) + 4 * fq); }
                unsigned pkd[4];
#pragma unroll
                for (int hf = 0; hf < 2; ++hf) { const int st = 2 * kb + hf; float gv[4];
#pragma unroll
                    for (int jj = 0; jj < 4; ++jj) { const int s = 16 * st + 4 * fq + jj; gv[jj] = (s <= trow) ? d[st][jj] * __expf(act - acs[hf][jj]) * dts[hf][jj] : 0.f; }
                    pkd[2 * hf] = pk2(gv[0], gv[1]); pkd[2 * hf + 1] = pk2(gv[2], gv[3]); }
                u32x4 w; w.x = pkd[0]; w.y = pkd[1]; w.z = pkd[2]; w.w = pkd[3];
                gfrag[kb] = __builtin_bit_cast(bf16x8, w);
            }
        }
        const float eact = __expf(act);
        const int grow = base + trow;
        f32x4 y[4];
#pragma unroll
        for (int pt = 0; pt < 4; ++pt) y[pt] = (f32x4){0.f, 0.f, 0.f, 0.f};
#pragma unroll
        for (int kk = 0; kk < 4; ++kk) {
            bf16x8 hf[4];
#pragma unroll
            for (int pt = 0; pt < 4; ++pt) hf[pt] = *(const LAS bf16x8*)(sH + (16 * pt + fr) * LROW + 32 * kk + 8 * fq);
#pragma unroll
            for (int pt = 0; pt < 4; ++pt) y[pt] = __builtin_amdgcn_mfma_f32_16x16x32_bf16(hf[pt], cf[kk], y[pt], 0, 0, 0);
        }
#pragma unroll
        for (int pt = 0; pt < 4; ++pt) y[pt] *= eact;
#pragma unroll
        for (int kb = 0; kb < 4; ++kb) {
            u32x2 x0[4], x1[4];
#pragma unroll
            for (int pt = 0; pt < 4; ++pt) { x0[pt] = tr4(sX, XROW, 32 * kb + 4 * fq, 16 * pt, fr); x1[pt] = tr4(sX, XROW, 32 * kb + 16 + 4 * fq, 16 * pt, fr); }
#pragma unroll
            for (int pt = 0; pt < 4; ++pt) { u32x4 w; w.x = x0[pt].x; w.y = x0[pt].y; w.z = x1[pt].x; w.w = x1[pt].y;
                y[pt] = __builtin_amdgcn_mfma_f32_16x16x32_bf16(__builtin_bit_cast(bf16x8, w), gfrag[kb], y[pt], 0, 0, 0); }
        }
        float ssq = 0.f;
        {
            u32x2 xx[4];
#pragma unroll
            for (int pt = 0; pt < 4; ++pt) xx[pt] = *(const LAS u32x2*)(sX + trow * XROW + 16 * pt + 4 * fq);
#pragma unroll
            for (int pt = 0; pt < 4; ++pt) {
                const int pc = 16 * pt + 4 * fq;
                const float zf[4] = {bflo(rz[pt].x), bfhi(rz[pt].x), bflo(rz[pt].y), bfhi(rz[pt].y)};
                const float xf[4] = {bflo(xx[pt].x), bfhi(xx[pt].x), bflo(xx[pt].y), bfhi(xx[pt].y)};
                float yo[4];
#pragma unroll
                for (int jj = 0; jj < 4; ++jj) { const float v = (y[pt][jj] + Dh * xf[jj]) * siluf_(zf[jj]); yo[jj] = v; ssq += v * v; }
                u32x2 w; w.x = pk2(yo[0], yo[1]); w.y = pk2(yo[2], yo[3]);
                *(u32x2*)(A2 + (size_t)grow * 4096 + h * 64 + pc) = w;
            }
        }
        ssq += __shfl_xor(ssq, 16); ssq += __shfl_xor(ssq, 32);
        if (fq == 0) YSS[(size_t)grow * 32 + h] = ssq;
        SSD_ISSUE_Z(cn);
        __syncthreads();
        {
            const float dec = __expf(sAc[127]);
            const int ptile = wid & 3, nt0 = (wid >> 2) * 4;
#pragma unroll
            for (int i = 0; i < 4; ++i) hacc[i] *= dec;
#pragma unroll
            for (int kk = 0; kk < 4; ++kk) {
                const int sb = 32 * kk + 8 * fq;
                const u32x2 xlo = tr4(sX, XROW, sb, 16 * ptile, fr), xhi = tr4(sX, XROW, sb + 4, 16 * ptile, fr);
                const f32x4 w0 = *(const LAS f32x4*)(sW + sb), w1 = *(const LAS f32x4*)(sW + sb + 4);
                u32x2 blo[4], bhi[4];
#pragma unroll
                for (int i = 0; i < 4; ++i) { blo[i] = tr4(sB, LROW, sb, 16 * (nt0 + i), fr); bhi[i] = tr4(sB, LROW, sb + 4, 16 * (nt0 + i), fr); }
                u32x4 w;
                w.x = pk2(bflo(xlo.x) * w0[0], bfhi(xlo.x) * w0[1]); w.y = pk2(bflo(xlo.y) * w0[2], bfhi(xlo.y) * w0[3]);
                w.z = pk2(bflo(xhi.x) * w1[0], bfhi(xhi.x) * w1[1]); w.w = pk2(bflo(xhi.y) * w1[2], bfhi(xhi.y) * w1[3]);
                const bf16x8 xa = __builtin_bit_cast(bf16x8, w);
#pragma unroll
                for (int i = 0; i < 4; ++i) { u32x4 bw; bw.x = blo[i].x; bw.y = blo[i].y; bw.z = bhi[i].x; bw.w = bhi[i].y;
                    hacc[i] = __builtin_amdgcn_mfma_f32_16x16x32_bf16(xa, __builtin_bit_cast(bf16x8, bw), hacc[i], 0, 0, 0); }
            }
#pragma unroll
            for (int i = 0; i < 4; ++i)
#pragma unroll
                for (int jj = 0; jj < 4; ++jj) sH[(16 * ptile + 4 * fq + jj) * LROW + 16 * (nt0 + i) + fr] = f2bf(hacc[i][jj]);
        }
        __syncthreads();
    }
#undef SSD_ISSUE
#undef SSD_ISSUE_Z
    { const int ptile = wid & 3, nt0 = (wid >> 2) * 4; float* dst = p.out + O_SP + ((size_t)(b * 32 + h) * 64) * 128;
#pragma unroll
        for (int i = 0; i < 4; ++i)
#pragma unroll
            for (int jj = 0; jj < 4; ++jj) dst[(16 * ptile + 4 * fq + jj) * 128 + 16 * (nt0 + i) + fr] = hacc[i][jj]; }
}

__device__ __forceinline__ void ssd_sample(const Params& p, LAS unsigned char* lds, int s, int g) {
    const int tid = tid_opaque(), wid = __builtin_amdgcn_readfirstlane(tid >> 6), lane = tid & 63, fr = lane & 15, fq = lane >> 4;
    LAS bf16_t* sXT = (LAS bf16_t*)(lds);
    LAS bf16_t* sBT = (LAS bf16_t*)(lds + 8192);
    LAS bf16_t* sBn = (LAS bf16_t*)(lds + 10240);
    LAS bf16_t* sCn = (LAS bf16_t*)(lds + 12288);
    LAS float* sCB = (LAS float*)(lds + 14336);
    LAS float* sDt2 = sCB + 64;
    LAS float* sAc2 = sDt2 + 64;
    const bf16_t* PROJ = (const bf16_t*)(p.ws + W_PROJ);
    const bf16_t* XACT = (const bf16_t*)(p.ws + W_XACT);
    const float* DT = (const float*)(p.ws + W_DT);
    bf16_t* A2 = (bf16_t*)(p.ws + W_A2);
    float* YSS = (float*)(p.ws + W_YSS);
    const int rbase = ROWS_P + s * 8;
    const int h = g * 8 + wid;
    const float* hsrc = p.state_ssm + ((size_t)s * 32 + h) * 8192 + (size_t)fr * 128 + 4 * fq;
    float* hdst = p.out + O_SS + ((size_t)s * 32 + h) * 8192 + (size_t)fr * 128 + 4 * fq;
    f32x4 ha[8], hb[8];
#define SMP_LOADH(dst, pt) do { _Pragma("unroll") for (int nt = 0; nt < 8; ++nt) dst[nt] = __builtin_nontemporal_load((const f32x4*)(hsrc + (pt) * 2048 + nt * 16)); } while (0)
    SMP_LOADH(ha, 0);
    float zv[4][4];
#pragma unroll
    for (int jj = 0; jj < 4; ++jj)
#pragma unroll
        for (int pt = 0; pt < 4; ++pt) zv[jj][pt] = bf2f(PROJ[(size_t)(rbase + ((4 * fq + jj) & 7)) * NPROJ + C_Z + h * 64 + 16 * pt + fr]);
    __builtin_amdgcn_sched_barrier(0);
    { const int row = tid >> 6, cgx = tid & 63; const u32x4 L = *(const u32x4*)(XACT + (size_t)(rbase + row) * CONVD + g * 512 + cgx * 8);
        LAS bf16_t* d = sXT + (cgx * 8) * 8 + row;
        d[0] = (bf16_t)(L.x & 0xffffu); d[8] = (bf16_t)(L.x >> 16); d[16] = (bf16_t)(L.y & 0xffffu); d[24] = (bf16_t)(L.y >> 16);
        d[32] = (bf16_t)(L.z & 0xffffu); d[40] = (bf16_t)(L.z >> 16); d[48] = (bf16_t)(L.w & 0xffffu); d[56] = (bf16_t)(L.w >> 16); }
    if (tid < 256) { const int which = tid >> 7, v = tid & 127, row = v >> 4, cg = v & 15;
        const u32x4 L = *(const u32x4*)(XACT + (size_t)(rbase + row) * CONVD + 2048 + which * 512 + g * 128 + cg * 8);
        *(LAS u32x4*)((which ? sCn : sBn) + row * 128 + cg * 8) = L;
        if (which == 0) { LAS bf16_t* d = sBT + (cg * 8) * 8 + row;
            d[0] = (bf16_t)(L.x & 0xffffu); d[8] = (bf16_t)(L.x >> 16); d[16] = (bf16_t)(L.y & 0xffffu); d[24] = (bf16_t)(L.y >> 16);
            d[32] = (bf16_t)(L.z & 0xffffu); d[40] = (bf16_t)(L.z >> 16); d[48] = (bf16_t)(L.w & 0xffffu); d[56] = (bf16_t)(L.w >> 16); } }
    else if (tid < 320) { const int l = tid - 256, hh = l >> 3, t = l & 7, h2 = g * 8 + hh;
        const float dt = DT[(size_t)(rbase + t) * 32 + h2];
        float v = dt * (-__expf(p.a_log[h2]));
#pragma unroll
        for (int o = 1; o < 8; o <<= 1) { const float nb = __shfl_up(v, o, 8); if (t >= o) v += nb; }
        sDt2[l] = dt; sAc2[l] = v; }
    __syncthreads();
    { const int pair = tid >> 3, part = tid & 7, t = pair >> 3, s2 = pair & 7; float d = 0.f;
        const u32x4 c0 = *(const LAS u32x4*)(sCn + t * 128 + 16 * part), c1 = *(const LAS u32x4*)(sCn + t * 128 + 16 * part + 8);
        const u32x4 b0 = *(const LAS u32x4*)(sBn + s2 * 128 + 16 * part), b1 = *(const LAS u32x4*)(sBn + s2 * 128 + 16 * part + 8);
        d += bflo(c0.x) * bflo(b0.x) + bfhi(c0.x) * bfhi(b0.x) + bflo(c0.y) * bflo(b0.y) + bfhi(c0.y) * bfhi(b0.y) + bflo(c0.z) * bflo(b0.z) + bfhi(c0.z) * bfhi(b0.z) + bflo(c0.w) * bflo(b0.w) + bfhi(c0.w) * bfhi(b0.w);
        d += bflo(c1.x) * bflo(b1.x) + bfhi(c1.x) * bfhi(b1.x) + bflo(c1.y) * bflo(b1.y) + bfhi(c1.y) * bfhi(b1.y) + bflo(c1.z) * bflo(b1.z) + bfhi(c1.z) * bfhi(b1.z) + bflo(c1.w) * bflo(b1.w) + bfhi(c1.w) * bfhi(b1.w);
        d += __shfl_xor(d, 1); d += __shfl_xor(d, 2); d += __shfl_xor(d, 4);
        if (part == 0) sCB[pair] = d; }
    __syncthreads();
    const int tl = fr & 7;
    float ac[8], dtv[8];
    { const f32x4 a0 = *(const LAS f32x4*)(sAc2 + wid * 8), a1 = *(const LAS f32x4*)(sAc2 + wid * 8 + 4), d0 = *(const LAS f32x4*)(sDt2 + wid * 8), d1 = *(const LAS f32x4*)(sDt2 + wid * 8 + 4);
#pragma unroll
      for (int t = 0; t < 4; ++t) { ac[t] = a0[t]; ac[4 + t] = a1[t]; dtv[t] = d0[t]; dtv[4 + t] = d1[t]; } }
    const float aT = ac[7], dec = __expf(aT), Dh = p.d_skip[h];
    float wv[8];
#pragma unroll
    for (int s2 = 0; s2 < 8; ++s2) wv[s2] = __expf(aT - ac[s2]) * dtv[s2];
    bf16x8 gfrag;
    { float actl = ac[0];
#pragma unroll
      for (int k = 1; k < 8; ++k) actl = (tl == k) ? ac[k] : actl;
      const f32x4 cb0 = *(const LAS f32x4*)(sCB + tl * 8), cb1 = *(const LAS f32x4*)(sCB + tl * 8 + 4);
      float gv[8];
#pragma unroll
      for (int s2 = 0; s2 < 8; ++s2) { const float cbv = s2 < 4 ? cb0[s2 & 3] : cb1[s2 & 3]; gv[s2] = (s2 <= tl && fq == 0) ? cbv * __expf(fminf(actl - ac[s2], 0.f)) * dtv[s2] : 0.f; }
      u32x4 w; w.x = pk2(gv[0], gv[1]); w.y = pk2(gv[2], gv[3]); w.z = pk2(gv[4], gv[5]); w.w = pk2(gv[6], gv[7]); gfrag = __builtin_bit_cast(bf16x8, w); }
    bf16x8 cfrag[4];
#pragma unroll
    for (int kk = 0; kk < 4; ++kk) { const u32x2 lo = *(const LAS u32x2*)(sCn + tl * 128 + 32 * kk + 4 * fq), hi = *(const LAS u32x2*)(sCn + tl * 128 + 32 * kk + 16 + 4 * fq);
        u32x4 w; w.x = lo.x; w.y = lo.y; w.z = hi.x; w.w = hi.y; cfrag[kk] = __builtin_bit_cast(bf16x8, w); }
    bf16x8 btf[8];
#pragma unroll
    for (int nt = 0; nt < 8; ++nt) { u32x4 w = *(const LAS u32x4*)(sBT + (16 * nt + fr) * 8); if (fq != 0) w = (u32x4){0u, 0u, 0u, 0u}; btf[nt] = __builtin_bit_cast(bf16x8, w); }
    float eact[4];
#pragma unroll
    for (int jj = 0; jj < 4; ++jj) { float a_ = ac[0];
#pragma unroll
        for (int k = 1; k < 8; ++k) a_ = (((4 * fq + jj) & 7) == k) ? ac[k] : a_;
        eact[jj] = __expf(a_); }
    float ssq[4] = {0.f, 0.f, 0.f, 0.f};
    auto ptile = [&](const f32x4 (&hv)[8], int pt) {
        const u32x4 xr = *(const LAS u32x4*)(sXT + (wid * 64 + 16 * pt + fr) * 8);
        const float xf[8] = {bflo(xr.x), bfhi(xr.x), bflo(xr.y), bfhi(xr.y), bflo(xr.z), bfhi(xr.z), bflo(xr.w), bfhi(xr.w)};
        f32x4 y = (f32x4){0.f, 0.f, 0.f, 0.f};
#pragma unroll
        for (int kk = 0; kk < 4; ++kk) { u32x4 w; w.x = pk2(hv[2 * kk][0], hv[2 * kk][1]); w.y = pk2(hv[2 * kk][2], hv[2 * kk][3]); w.z = pk2(hv[2 * kk + 1][0], hv[2 * kk + 1][1]); w.w = pk2(hv[2 * kk + 1][2], hv[2 * kk + 1][3]);
            y = __builtin_amdgcn_mfma_f32_16x16x32_bf16(cfrag[kk], __builtin_bit_cast(bf16x8, w), y, 0, 0, 0); }
#pragma unroll
        for (int jj = 0; jj < 4; ++jj) y[jj] *= eact[jj];
        { u32x4 w = fq == 0 ? xr : (u32x4){0u, 0u, 0u, 0u}; y = __builtin_amdgcn_mfma_f32_16x16x32_bf16(gfrag, __builtin_bit_cast(bf16x8, w), y, 0, 0, 0); }
        if (fq < 2) {
            float xt[4];
#pragma unroll
            for (int jj = 0; jj < 4; ++jj) xt[jj] = fq == 0 ? xf[jj] : xf[4 + jj];
#pragma unroll
            for (int jj = 0; jj < 4; ++jj) { const float v = (y[jj] + Dh * xt[jj]) * siluf_(zv[jj][pt]); ssq[jj] += v * v;
                A2[(size_t)(rbase + 4 * fq + jj) * 4096 + h * 64 + 16 * pt + fr] = f2bf(v); }
        }
        u32x4 xw; xw.x = pk2(xf[0] * wv[0], xf[1] * wv[1]); xw.y = pk2(xf[2] * wv[2], xf[3] * wv[3]); xw.z = pk2(xf[4] * wv[4], xf[5] * wv[5]); xw.w = pk2(xf[6] * wv[6], xf[7] * wv[7]);
        if (fq != 0) xw = (u32x4){0u, 0u, 0u, 0u};
        const bf16x8 xwf = __builtin_bit_cast(bf16x8, xw);
#pragma unroll
        for (int nt = 0; nt < 8; ++nt) { f32x4 acc = hv[nt] * dec; acc = __builtin_amdgcn_mfma_f32_16x16x32_bf16(btf[nt], xwf, acc, 0, 0, 0);
            *(f32x4*)(hdst + pt * 2048 + nt * 16) = acc; }
    };
    SMP_LOADH(hb, 1); __builtin_amdgcn_sched_barrier(0);
    ptile(ha, 0); SMP_LOADH(ha, 2); __builtin_amdgcn_sched_barrier(0);
    ptile(hb, 1); SMP_LOADH(hb, 3); __builtin_amdgcn_sched_barrier(0);
    ptile(ha, 2); __builtin_amdgcn_sched_barrier(0);
    ptile(hb, 3);
#undef SMP_LOADH
#pragma unroll
    for (int jj = 0; jj < 4; ++jj) { float v = ssq[jj]; v += __shfl_xor(v, 1); v += __shfl_xor(v, 2); v += __shfl_xor(v, 4); v += __shfl_xor(v, 8); ssq[jj] = v; }
    if (fr == 0 && fq < 2) {
#pragma unroll
        for (int jj = 0; jj < 4; ++jj) YSS[(size_t)(rbase + 4 * fq + jj) * 32 + h] = ssq[jj]; }
    __syncthreads();
}
__device__ __forceinline__ void phase_elem(const Params& p, unsigned char* smem) {
    phase_conv(p);
    for (int it = blockIdx.x; it < 544 + 512; it += gridDim.x) {
        if (it < 544) pool_prompt(p, smem, it / 136, (it % 136) >> 2, it & 3);
        else { const int j = it - 544; pool_sample(p, j >> 2, j & 3); }
    }
}
__device__ __forceinline__ void phase_ssd(const Params& p, unsigned char* smem) {
    const int G = gridDim.x, bid = blockIdx.x;
    if (bid < 128) {
        const int xcd = bid & 7, slot = bid >> 3, pair = xcd * 2 + (slot >> 3);
        ssd_prompt(p, (LAS unsigned char*)smem, pair >> 2, (pair & 3) * 8 + (slot & 7)); }
    else for (int it = bid - 128; it < 512; it += G - 128) ssd_sample(p, (LAS unsigned char*)smem, it >> 2, it & 3);
}

__device__ __forceinline__ void phase_ynorm(const Params& p, int vbid, int vG) {
    const int tid = tid_opaque(); const int wid = tid >> 6, lane = tid & 63;
    bf16_t* A2 = (bf16_t*)(p.ws + W_A2); const float* YSS = (const float*)(p.ws + W_YSS);
    for (int it = vbid * 8 + wid; it < TROWS * 4; it += vG * 8) {
        const int row = it >> 2, g = it & 3;
        const f32x4 s0 = *(const f32x4*)(YSS + (size_t)row * 32 + g * 8), s1 = *(const f32x4*)(YSS + (size_t)row * 32 + g * 8 + 4);
        const float ss = s0[0] + s0[1] + s0[2] + s0[3] + s1[0] + s1[1] + s1[2] + s1[3];
        const float rs = rsqrtf(ss * (1.0f / 512.0f) + EPS);
        bf16_t* ptr = A2 + (size_t)row * 4096 + g * 512 + lane * 8;
        const u32x4 v = *(const u32x4*)ptr;
        const f32x4 w0 = *(const f32x4*)(p.ssd_norm_w + g * 512 + lane * 8), w1 = *(const f32x4*)(p.ssd_norm_w + g * 512 + lane * 8 + 4);
        u32x4 o; o.x = pk2(bflo(v.x) * rs * w0[0], bfhi(v.x) * rs * w0[1]); o.y = pk2(bflo(v.y) * rs * w0[2], bfhi(v.y) * rs * w0[3]);
        o.z = pk2(bflo(v.z) * rs * w1[0], bfhi(v.z) * rs * w1[1]); o.w = pk2(bflo(v.w) * rs * w1[2], bfhi(v.w) * rs * w1[3]);
        *(u32x4*)ptr = o;
    }
}
__device__ __forceinline__ void phase_final(const Params& p, int rb, int re, int vbid, int vG) {
    const int tid = tid_opaque(); const int wid = tid >> 6, lane = tid & 63;
    const float* RSS = (const float*)(p.ws + W_RSS);
    for (int r = rb + vbid * 8 + wid; r < re; r += vG * 8) {
        float* dst = row_dst(p, r); if (!dst) continue;
        float ss = lane < 32 ? RSS[(size_t)r * 32 + lane] : 0.f;
#pragma unroll
        for (int o = 32; o >= 1; o >>= 1) ss += __shfl_xor(ss, o);
        const float rs = rsqrtf(ss * (1.0f / DM) + EPS);
#pragma unroll
        for (int i = 0; i < 8; ++i) { f32x4 v = ((f32x4*)dst)[lane + 64 * i]; const f32x4 w = ((const f32x4*)p.final_norm_w)[lane + 64 * i];
            v[0] *= rs * w[0]; v[1] *= rs * w[1]; v[2] *= rs * w[2]; v[3] *= rs * w[3]; ((f32x4*)dst)[lane + 64 * i] = v; }
    }
}


#define XB_TMO      128
#define XB_XCNT(j)  (256  + 64 * (j))
#define XB_XSUB(j)  (1280 + 64 * (j))
#define XB_XGEN(j)  (2304 + 64 * (j))
#define XB_TOP      3328
#define XB_TOPGEN   3392
#define XCD_BAR_WORDS 3456
#define XB_SPIN_CAP (1u << 18)
__device__ __forceinline__ unsigned xb_ld(unsigned* p)              { return __hip_atomic_load(p, __ATOMIC_RELAXED, __HIP_MEMORY_SCOPE_AGENT); }
__device__ __forceinline__ unsigned xb_add(unsigned* p, unsigned v) { return __hip_atomic_fetch_add(p, v, __ATOMIC_RELAXED, __HIP_MEMORY_SCOPE_AGENT); }
__device__ __forceinline__ unsigned xb_xcc_id() { return (unsigned)__builtin_amdgcn_s_getreg((3 << 11) | 20) & 0xFu; }
#define XB_SPIN(cond, bar) do { unsigned _sp = 0; while (cond) { __builtin_amdgcn_s_sleep(1); \
    if ((++_sp & 255u) == 0u) { if (xb_ld(&(bar)[XB_TMO])) break; if (_sp > XB_SPIN_CAP) { atomicAdd(&(bar)[XB_TMO], 1u); break; } } } } while (0)
struct XcdBarrier { unsigned* bar; unsigned x; volatile LAS unsigned* st; };
__device__ __forceinline__ XcdBarrier xcd_barrier_post(unsigned* bar, volatile LAS unsigned* st) {
    XcdBarrier b; b.bar = bar; b.x = xb_xcc_id(); b.st = st;
    if (threadIdx.x == 0) (void)xb_add(&bar[XB_XCNT(b.x)], 1u);
    return b;
}
__device__ __forceinline__ void xcd_barrier_complete(unsigned* bar, unsigned x, unsigned& nloc, unsigned& nx) {
    const unsigned G = gridDim.x * gridDim.y * gridDim.z;
    unsigned sum, cnt, mine, sp = 0u;
    for (;;) {
        sum = 0u; cnt = 0u; mine = 0u;
#pragma unroll
        for (unsigned j = 0; j < 16; ++j) { const unsigned c = xb_ld(&bar[XB_XCNT(j)]); sum += c; cnt += (c > 0u) ? 1u : 0u; mine = (j == x) ? c : mine; }
        if (sum == G) break;
        __builtin_amdgcn_s_sleep(1);
        if ((++sp & 255u) == 0u) { if (xb_ld(&bar[XB_TMO])) break; if (sp > XB_SPIN_CAP) { atomicAdd(&bar[XB_TMO], 1u); break; } }
    }
    nloc = mine > 0u ? mine : 1u; nx = cnt > 0u ? cnt : 1u;
}
__device__ __forceinline__ void xcd_barrier(const XcdBarrier& b) {
    asm volatile("s_waitcnt vmcnt(0)" ::: "memory");
    __syncthreads();
    if (threadIdx.x == 0) {
        unsigned* bar = b.bar;
        __builtin_amdgcn_s_waitcnt(0);
        unsigned nloc = b.st[0], nx = b.st[1];
        if (nloc == 0u) { xcd_barrier_complete(bar, b.x, nloc, nx); b.st[0] = nloc; b.st[1] = nx; }
        const unsigned old = xb_add(&bar[XB_XSUB(b.x)], 1u);
        const unsigned gen = old / nloc;
        if (old + 1u == (gen + 1u) * nloc) {
            __builtin_amdgcn_fence(__ATOMIC_RELEASE, "agent");
            asm volatile("s_waitcnt vmcnt(0)" ::: "memory");
            const unsigned og = xb_add(&bar[XB_TOP], 1u);
            const unsigned tg = og / nx;
            if (og + 1u == (tg + 1u) * nx) xb_add(&bar[XB_TOPGEN], 1u);
            else XB_SPIN(xb_ld(&bar[XB_TOPGEN]) == tg, bar);
            __builtin_amdgcn_fence(__ATOMIC_ACQUIRE, "agent");
            xb_add(&bar[XB_XGEN(b.x)], 1u);
            asm volatile("s_waitcnt vmcnt(0)" ::: "memory");
        } else {
            XB_SPIN(xb_ld(&bar[XB_XGEN(b.x)]) == gen, bar);
            __builtin_amdgcn_fence(__ATOMIC_ACQUIRE, "agent");
            asm volatile("s_waitcnt vmcnt(0)" ::: "memory");
        }
    }
    __syncthreads();
}

__global__ void __launch_bounds__(512, 2) fwd_megakernel(Params p) {
    extern __shared__ __attribute__((aligned(16))) unsigned char shm[];
    cg::grid_group grid = cg::this_grid();
    LAS unsigned char* lds = (LAS unsigned char*)shm;
    bf16_t* XN = (bf16_t*)(p.ws + W_XN); bf16_t* PROJ = (bf16_t*)(p.ws + W_PROJ); bf16_t* A2 = (bf16_t*)(p.ws + W_A2);
    volatile LAS unsigned* xst = (volatile LAS unsigned*)(lds + LDS_BYTES - 16);
    if (threadIdx.x == 0) { xst[0] = 0u; xst[1] = 0u; }
    __syncthreads();
    if (blockIdx.x == 0 && threadIdx.x < 64) {
        unsigned* bw = (unsigned*)(p.ws + W_BAR);
        for (int i = threadIdx.x; i < 4096; i += 64) __hip_atomic_store(bw + i, 0u, __ATOMIC_RELAXED, __HIP_MEMORY_SCOPE_AGENT);
        asm volatile("s_waitcnt vmcnt(0)" ::: "memory");
        __builtin_amdgcn_fence(__ATOMIC_RELEASE, "agent");
        asm volatile("s_waitcnt vmcnt(0)" ::: "memory");
    }
    grid.sync();
    const XcdBarrier xb = xcd_barrier_post((unsigned*)(p.ws + W_BAR), xst);
    phase_prep(p, (float*)shm);
    xcd_barrier(xb);
    { GemmD g{XN, (const bf16_t*)(p.ws + W_WINT), DM, DM, DM, TROWS / BM, NPROJ / BM, 0, 0, 1, 0, (int)blockIdx.x, (int)gridDim.x, 0, (TROWS / BM) * (NPROJ / BM), 0};
      EpiProj e{PROJ, (float*)(p.ws + W_DTRAW)};
      gemm_phase(lds, g, e); }
    xcd_barrier(xb);
    phase_elem(p, shm);
    xcd_barrier(xb);
    phase_ssd(p, shm);
    xcd_barrier(xb);
    { GemmD g{XN  , (const bf16_t*)(p.ws + W_WMIX), DM, 512, 512, TROWS / BM, DM / BM, 2, 512, 1, 0, (int)blockIdx.x, (int)gridDim.x, 0, (TROWS / BM) * (DM / BM), 0};
      EpiMix e{PROJ, A2, p.pool_mix_b, p.pool_scale};
      gemm_phase(lds, g, e); }
    if (blockIdx.x >= 48) phase_ynorm(p, blockIdx.x - 48, gridDim.x - 48);
    xcd_barrier(xb);
#pragma unroll 1
    for (int stage = 0; stage < 3; ++stage) {
        const int bid = blockIdx.x;
        float* Fh = (float*)(p.ws + W_XACT);
        if (stage == 0) {
            GemmD g{A2, (const bf16_t*)(p.ws + W_WSP), 4096, 4096, 2048, 32, DM / BM, 0, 0, 2, 0, bid, 256, 0, 256, 0};
            EpiMerged e{PROJ, XN  };
            gemm_phase(lds, g, e);
        } else if (stage == 1 && bid < 96) {
            const int which = bid >= 48 ? 1 : 0;
            GemmD g{A2 + which * 2048, (const bf16_t*)(p.ws + W_WSP) + which * 2048, 4096, 4096, 2048, 6, DM / BM, 0, 0, 1, 32, bid - 48 * which, 48, 0, 48, 0};
            EpiHalf e{PROJ, Fh + (size_t)which * 1536 * DM, which};
            gemm_phase(lds, g, e);
        } else if (stage == 1 || bid < 144) {
            const bool tailp = (stage == 2 && bid >= 96);
            GemmD g{XN  , (const bf16_t*)(p.ws + W_WOUT), DM, DM, DM, tailp ? 6 : 32, DM / BM, 0, 0, 1, tailp ? 32 : 0,
                    stage == 1 ? bid - 96 : (tailp ? bid - 96 : bid), stage == 1 ? 160 : (tailp ? 48 : 96), (stage == 2 && !tailp) ? 160 : 0, stage == 1 ? 160 : (tailp ? 48 : 256), tailp ? 0 : 1};
            EpiOut e{p, (float*)(p.ws + W_RSS)};
            gemm_phase(lds, g, e);
        } else if (stage == 2) {
            phase_final(p, 0, 5120, bid - 144, 112);
        }
        xcd_barrier(xb);
        if (stage == 1) {
            const int tid = tid_opaque();
            for (int i = bid * 512 + tid; i < 1536 * DM / 8; i += 256 * 512) {
                const f32x4 a0 = *(const f32x4*)(Fh + (size_t)i * 8), a1 = *(const f32x4*)(Fh + (size_t)i * 8 + 4), b0 = *(const f32x4*)(Fh + (size_t)1536 * DM + (size_t)i * 8), b1 = *(const f32x4*)(Fh + (size_t)1536 * DM + (size_t)i * 8 + 4);
                u32x4 w; w.x = pk2(a0[0] + b0[0], a0[1] + b0[1]); w.y = pk2(a0[2] + b0[2], a0[3] + b0[3]); w.z = pk2(a1[0] + b1[0], a1[1] + b1[1]); w.w = pk2(a1[2] + b1[2], a1[3] + b1[3]);
                *(u32x4*)(XN + (size_t)8192 * DM + (size_t)i * 8) = w; }
            xcd_barrier(xb);
        }
    }
    phase_final(p, 5120, TROWS, blockIdx.x, gridDim.x);
}

extern "C" void kernel_launch(void* const* d_in, const int* in_sizes, int n_in, void* d_out, int out_size, void* d_ws, size_t ws_size, hipStream_t stream) {
    static int grid_blocks = 0;
    if (!grid_blocks) {
        int dev = 0, cus = 0, per_cu = 0;
        hipGetDevice(&dev);
        hipDeviceGetAttribute(&cus, hipDeviceAttributeMultiprocessorCount, dev);
        hipFuncSetAttribute((const void*)fwd_megakernel, hipFuncAttributeMaxDynamicSharedMemorySize, LDS_BYTES);
        hipOccupancyMaxActiveBlocksPerMultiprocessor(&per_cu, fwd_megakernel, 512, LDS_BYTES);
        if (per_cu > 1) per_cu = 1;
        grid_blocks = cus * per_cu;
        grid_blocks &= ~7;
        if (grid_blocks != 256) { fprintf(stderr, "this kernel's static schedule needs exactly 256 resident workgroups (got %d)\n", grid_blocks); grid_blocks = -1; }
    }
    if (ws_size < W_END || grid_blocks <= 0) { fprintf(stderr, "workspace too small or no occupancy (%zu, %d)\n", ws_size, grid_blocks); return; }
    Params p{};
    const float** f = (const float**)&p;
    for (int i = 0; i < 21; ++i) f[i] = (const float*)d_in[i];
    p.out = (float*)d_out; p.ws = (unsigned char*)d_ws;
    void* args[] = {&p};
    hipError_t e = hipLaunchCooperativeKernel((void*)fwd_megakernel, dim3(grid_blocks), dim3(512), args, LDS_BYTES, stream);
    if (e != hipSuccess) fprintf(stderr, "cooperative launch failed: %s (grid %d)\n", hipGetErrorString(e), grid_blocks);
}
```

```cpp
#include <hip/hip_runtime.h>
#include <hip/hip_cooperative_groups.h>
#include <cstdio>
namespace cg = cooperative_groups;

#define LAS __attribute__((address_space(3)))
typedef unsigned short bf16_t;
typedef short bf16x8 __attribute__((ext_vector_type(8)));
typedef float f32x4 __attribute__((ext_vector_type(4)));
typedef unsigned u32x4 __attribute__((ext_vector_type(4)));
typedef unsigned u32x2 __attribute__((ext_vector_type(2)));

constexpr int DM = 2048;
constexpr int TP = 2176;
constexpr int PADR = 112;
constexpr int ROWS_P = 4 * TP;
constexpr int TROWS = ROWS_P + 1024;
constexpr int NPROJ = 13568;
constexpr int C_Z = 0, C_XBC = 2048, C_ZP = 5120, C_U = 7168, C_GS = 9216, C_GP = 11264, C_DT = 13312;
constexpr int CONVD = 3072;
constexpr float EPS = 1e-6f;
constexpr size_t O_YP = 0, O_YS = 16777216, O_CP = 18874368, O_SP = 18911232, O_PP = 19959808, O_CS = 20082688, O_SS = 21262336, O_PS = 54816768;
constexpr size_t W_XN = 0;
constexpr size_t W_WINT = 39845888;
constexpr size_t W_WSP = W_WINT + 55574528;
constexpr size_t W_WMIX = W_WSP + 16777216;
constexpr size_t W_WOUT = W_WMIX + 2097152;
constexpr size_t W_PROJ = W_WOUT + 8388608;
constexpr size_t W_DTRAW = W_PROJ + 263979008;
constexpr size_t W_A2 = W_DTRAW + 1245184;
constexpr size_t W_YSS = W_A2 + 79691776;
constexpr size_t W_RSS = W_YSS + 1245184;
constexpr size_t W_XACT = W_RSS + 1245184;
constexpr size_t W_AC = W_XACT + 59768832;
constexpr size_t W_BAR = W_AC + 1114112;
constexpr size_t W_DT = W_BAR + 16384;
constexpr size_t W_END = W_DT + 1245184;
constexpr int LDS_BYTES = 147456;

struct Params {
    const float *x_prompt, *x_sample, *state_conv, *state_ssm, *state_pool, *meta, *norm_w, *w_in, *conv_w, *conv_b, *dt_bias, *a_log, *d_skip,
        *ssd_norm_w, *w_proj_ssd, *pool_mix_w, *pool_mix_b, *pool_scale, *w_proj_pool, *w_out, *final_norm_w;
    float* out;
    unsigned char* ws;
};

__device__ __forceinline__ int tid_opaque() { int t = threadIdx.x; asm volatile("" : "+v"(t)); return t; }
__device__ __forceinline__ float bf2f(unsigned b) { return __uint_as_float(b << 16); }
__device__ __forceinline__ float bflo(unsigned w) { return __uint_as_float(w << 16); }
__device__ __forceinline__ float bfhi(unsigned w) { return __uint_as_float(w & 0xffff0000u); }
__device__ __forceinline__ unsigned pk2(float lo, float hi) { unsigned r; asm("v_cvt_pk_bf16_f32 %0, %1, %2" : "=v"(r) : "v"(lo), "v"(hi)); return r; }
__device__ __forceinline__ bf16_t f2bf(float f) { return (bf16_t)(pk2(f, 0.f) & 0xffffu); }
__device__ __forceinline__ float sigmoidf_(float x) { return __builtin_amdgcn_rcpf(1.0f + __expf(-x)); }
__device__ __forceinline__ float siluf_(float x) { return x * __builtin_amdgcn_rcpf(1.0f + __expf(-x)); }
__device__ __forceinline__ float softplusf_(float x) { return x > 20.f ? x : log1pf(__expf(x)); }
__device__ __forceinline__ const float* row_src(const Params& p, int r) {
    if (r < ROWS_P) { const int b = r / TP, t = r - b * TP;
        if (t < PADR) return nullptr;
        if (t < 128) return p.meta + (size_t)(t - PADR) * DM;
        return p.x_prompt + ((size_t)b * 2048 + (t - 128)) * DM; }
    return p.x_sample + (size_t)(r - ROWS_P) * DM;
}
__device__ __forceinline__ float* row_dst(const Params& p, int r) {
    if (r < ROWS_P) { const int b = r / TP, t = r - b * TP;
        if (t < 128) return nullptr;
        return p.out + O_YP + ((size_t)b * 2048 + (t - 128)) * DM; }
    return p.out + O_YS + (size_t)(r - ROWS_P) * DM;
}

constexpr int BM = 256, BK = 64, HALF = 128, HTB = HALF * BK * 2, NXCD = 8, WGM = 8;
__device__ __forceinline__ int lds_byte(int r, int c) { const int st = (r >> 4) * 2 + (c >> 5), rr = r & 15, cc = c & 31, ob = rr * 64 + cc * 2; return st * 1024 + (ob ^ (((ob >> 9) & 1) << 5)); }
__device__ __forceinline__ void stage_rc(int b, int& R, int& C) { const int st = b / 1024, sb = b % 1024, swz = sb ^ (((sb >> 9) & 1) << 5); R = (st >> 1) * 16 + swz / 64; C = (st & 1) * 32 + (swz % 64) / 2; }
__device__ __forceinline__ int perm32(int rho) { const int n = rho >> 4, i = rho & 15; return 8 * (i >> 2) + 4 * n + (i & 3); }
struct Unit { int pm, pn, sub; };
struct GemmD { const bf16_t* A; const bf16_t* Bt; int lda, ldb, K, nM, nN, a_kdiv, a_kstride, nsub, pm_off, vbid, vG, t0, tmax, linear; };
__device__ __forceinline__ bool unit_next(const GemmD& g, int i, Unit& u) {
    u.sub = g.nsub == 2 ? (i & 1) : 0; if (g.nsub == 2) i >>= 1;
    const int nwg = g.nM * g.nN; const long L = (long)g.t0 + (long)i * g.vG + g.vbid; if (L >= g.tmax) return false;
    if (g.linear) { u.pm = g.pm_off + (int)L / g.nN; u.pn = (int)L % g.nN; return true; }
    int wgid = (int)L; { const int q = nwg / NXCD, r = nwg % NXCD, xcd = wgid % NXCD, off = wgid / NXCD; wgid = (xcd < r ? xcd * (q + 1) : r * (q + 1) + (xcd - r) * q) + off; }
    const int nig = WGM * g.nN, gid = wgid / nig, fm = gid * WGM, gsz = (g.nM - fm) < WGM ? (g.nM - fm) : WGM;
    u.pm = g.pm_off + fm + ((wgid % nig) % gsz); u.pn = (wgid % nig) / gsz; return true;
}
__device__ __forceinline__ const char* unit_a(const GemmD& g, const Unit& u) { return (const char*)(g.A + (size_t)u.pm * BM * g.lda + (g.a_kdiv ? (u.pn / g.a_kdiv) * g.a_kstride : 0) + u.sub * g.K); }
__device__ __forceinline__ const char* unit_b(const GemmD& g, const Unit& u) { return (const char*)(g.Bt + (size_t)u.pn * BM * g.ldb + u.sub * g.K); }

template <class Epi>
__device__ __forceinline__ void gemm_phase(LAS unsigned char* lds, const GemmD g, const Epi& E) {
    const int tid = tid_opaque(), wid = __builtin_amdgcn_readfirstlane(tid >> 6), lane = tid & 63, wr = wid >> 2, wc = wid & 3, fr = lane & 15, fq = lane >> 4;
    const int K = g.K, nt = K / BK;
    unsigned voffA[2], voffB[2];
#pragma unroll
    for (int i = 0; i < 2; ++i) { int R, C; stage_rc(tid * 16 + i * 8192, R, C); const int Rb = (R & ~31) + perm32(R & 31);
        voffA[i] = (unsigned)(R * g.lda + C) * 2u; voffB[i] = (unsigned)(Rb * g.ldb + C) * 2u; }
    const size_t kstep = (size_t)(BK * 2);
    const size_t hstepA = (size_t)HALF * g.lda * 2, hstepB = (size_t)HALF * g.ldb * 2;
    const unsigned ldsw = (unsigned)wid * 1024u;
    const int aoff = lds_byte(wr * 64 + fr, fq * 8), boff = lds_byte(wc * 32 + fr, fq * 8);
#define PG8_SA(b, h) (((b) * 2 + (h)) * HTB)
#define PG8_SB(b, h) ((4 + (b) * 2 + (h)) * HTB)
#define PG8_STAGE(bufoff, gbase, voff) do { _Pragma("unroll") for (int _i = 0; _i < 2; ++_i) \
        __builtin_amdgcn_global_load_lds((const unsigned*)((const char*)(gbase) + (voff)[_i]), (LAS unsigned*)(lds + (bufoff) + ldsw + _i * 8192), 16, 0, 0); } while (0)
#define PG8_LDA(dst, b, h) do { _Pragma("unroll") for (int m = 0; m < 4; ++m) _Pragma("unroll") for (int k = 0; k < 2; ++k) dst[m][k] = *(const LAS bf16x8*)(lds + PG8_SA(b, h) + aoff + m * 2048 + k * 1024); } while (0)
#define PG8_LDB(dst, b, h) do { _Pragma("unroll") for (int n = 0; n < 2; ++n) _Pragma("unroll") for (int k = 0; k < 2; ++k) dst[n][k] = *(const LAS bf16x8*)(lds + PG8_SB(b, h) + boff + n * 2048 + k * 1024); } while (0)
#define PG8_MMA(ai, bj, At, Bt) do { __builtin_amdgcn_s_setprio(1); _Pragma("unroll") for (int m = 0; m < 4; ++m) _Pragma("unroll") for (int n = 0; n < 2; ++n) _Pragma("unroll") for (int k = 0; k < 2; ++k) \
        acc[ai][bj][m][n] = __builtin_amdgcn_mfma_f32_16x16x32_bf16(Bt[n][k], At[m][k], acc[ai][bj][m][n], 0, 0, 0); __builtin_amdgcn_s_setprio(0); } while (0)
#define PG8_WAIT_V(n) asm volatile("s_waitcnt vmcnt(" #n ")" ::: "memory")
#define PG8_WAIT_L(n) asm volatile("s_waitcnt lgkmcnt(" #n ")" ::: "memory")
#define PG8_BAR __builtin_amdgcn_s_barrier()
#define PG8_SCHED __builtin_amdgcn_sched_barrier(0)
    Unit cur, nxt; int ui = 0;
    if (!unit_next(g, 0, cur)) return;
    f32x4 acc[2][2][4][2];
#pragma unroll
    for (int a = 0; a < 2; ++a)
#pragma unroll
        for (int b = 0; b < 2; ++b)
#pragma unroll
            for (int m = 0; m < 4; ++m)
#pragma unroll
                for (int n = 0; n < 2; ++n) acc[a][b][m][n] = (f32x4){0.f, 0.f, 0.f, 0.f};
    bf16x8 At[4][2], B0[2][2], B1[2][2];
    const char* cA = unit_a(g, cur); const char* cB = unit_b(g, cur);
    PG8_STAGE(PG8_SB(0, 0), cB, voffB); PG8_STAGE(PG8_SA(0, 0), cA, voffA); PG8_STAGE(PG8_SB(0, 1), cB + hstepB, voffB); PG8_STAGE(PG8_SA(0, 1), cA + hstepA, voffA);
    if (wr == 1) PG8_BAR;
    PG8_WAIT_V(4); PG8_BAR;
    PG8_STAGE(PG8_SB(1, 0), cB + kstep, voffB); PG8_STAGE(PG8_SA(1, 0), cA + kstep, voffA); PG8_STAGE(PG8_SB(1, 1), cB + hstepB + kstep, voffB);
    PG8_WAIT_V(6); PG8_BAR;
    for (;;) {
        const bool has_next = unit_next(g, ui + 1, nxt);
        const char* nA = has_next ? unit_a(g, nxt) : cA; const char* nB = has_next ? unit_b(g, nxt) : cB;
#define PG8_KITER(t) do { \
            const bool last = ((t) == nt - 2); \
            const char* a1 = cA + (size_t)((t) + 1) * kstep; \
            const char* a2 = last ? nA : cA + (size_t)((t) + 2) * kstep; const char* b2 = last ? nB : cB + (size_t)((t) + 2) * kstep; \
            const char* a3 = a2 + kstep; const char* b3 = b2 + kstep; \
            PG8_LDB(B0, 0, 0); PG8_SCHED; PG8_LDA(At, 0, 0); PG8_STAGE(PG8_SA(1, 1), a1 + hstepA, voffA); \
            PG8_WAIT_L(8); PG8_BAR; PG8_WAIT_L(0); PG8_MMA(0, 0, At, B0); PG8_BAR; PG8_SCHED; \
            PG8_LDB(B1, 0, 1); PG8_STAGE(PG8_SB(0, 0), b2, voffB); \
            PG8_BAR; PG8_WAIT_L(0); PG8_MMA(0, 1, At, B1); PG8_BAR; \
            PG8_LDA(At, 0, 1); PG8_STAGE(PG8_SA(0, 0), a2, voffA); \
            PG8_BAR; PG8_WAIT_L(0); PG8_MMA(1, 0, At, B0); PG8_BAR; PG8_SCHED; \
            PG8_STAGE(PG8_SB(0, 1), b2 + hstepB, voffB); \
            PG8_WAIT_V(6); PG8_BAR; PG8_MMA(1, 1, At, B1); PG8_BAR; \
            PG8_LDB(B0, 1, 0); PG8_SCHED; PG8_LDA(At, 1, 0); PG8_STAGE(PG8_SA(0, 1), a2 + hstepA, voffA); \
            PG8_WAIT_L(8); PG8_BAR; PG8_WAIT_L(0); PG8_MMA(0, 0, At, B0); PG8_BAR; PG8_SCHED; \
            PG8_LDB(B1, 1, 1); PG8_STAGE(PG8_SB(1, 0), b3, voffB); \
            PG8_BAR; PG8_WAIT_L(0); PG8_MMA(0, 1, At, B1); PG8_BAR; \
            PG8_LDA(At, 1, 1); PG8_STAGE(PG8_SA(1, 0), a3, voffA); \
            PG8_BAR; PG8_WAIT_L(0); PG8_MMA(1, 0, At, B0); PG8_BAR; PG8_SCHED; \
            PG8_STAGE(PG8_SB(1, 1), b3 + hstepB, voffB); \
            PG8_WAIT_V(6); PG8_BAR; PG8_MMA(1, 1, At, B1); PG8_BAR; } while (0)
        for (int t = 0; t < nt; t += 2) PG8_KITER(t);
#undef PG8_KITER
        bool keep = false;
        if constexpr (Epi::MID) { if (cur.sub == 0) { E.mid(acc, cur, wr, wc, fr, fq); keep = true; } else E(acc, cur, wr, wc, fr, fq); }
        else E(acc, cur, wr, wc, fr, fq);
        if (!has_next) break;
        cur = nxt; cA = nA; cB = nB; ++ui;
        if (keep) continue;
#pragma unroll
        for (int a = 0; a < 2; ++a)
#pragma unroll
            for (int b = 0; b < 2; ++b)
#pragma unroll
                for (int m = 0; m < 4; ++m)
#pragma unroll
                    for (int n = 0; n < 2; ++n) acc[a][b][m][n] = (f32x4){0.f, 0.f, 0.f, 0.f};
    }
    PG8_WAIT_V(0);
    if (wr == 0) PG8_BAR;
    PG8_BAR;
#undef PG8_SA
#undef PG8_SB
#undef PG8_STAGE
#undef PG8_LDA
#undef PG8_LDB
#undef PG8_MMA
#undef PG8_WAIT_V
#undef PG8_WAIT_L
#undef PG8_BAR
#undef PG8_SCHED
}

struct EpiProj {
    static constexpr bool MID = false;
    bf16_t* proj; float* dtraw;
    __device__ __forceinline__ void mid(f32x4 (&)[2][2][4][2], const Unit&, int, int, int, int) const {}
    __device__ __forceinline__ void operator()(const f32x4 (&acc)[2][2][4][2], const Unit& u, int wr, int wc, int fr, int fq) const {
        const int row0 = u.pm * BM + wr * 64 + fr, col0 = u.pn * BM + wc * 32 + 8 * fq;
        const bool sig = (u.pn >= 36 && u.pn < 52), isdt = (u.pn == 52);
#pragma unroll
        for (int ai = 0; ai < 2; ++ai)
#pragma unroll
            for (int m = 0; m < 4; ++m) { const int row = row0 + ai * HALF + m * 16;
#pragma unroll
                for (int bj = 0; bj < 2; ++bj) { const f32x4 v0 = acc[ai][bj][m][0], v1 = acc[ai][bj][m][1]; const int col = col0 + bj * HALF;
                    if (sig) {
                        const int c = (col - C_GS) >> 1;
                        float ra[4], gp[4];
#pragma unroll
                        for (int j = 0; j < 4; ++j) { const float ea = __expf(-fminf(fmaxf(v0[j], -30.f), 30.f)), eb = __expf(-fminf(fmaxf(v1[j], -30.f), 30.f)); gp[j] = __builtin_amdgcn_rcpf(1.0f + eb); ra[j] = (1.0f + eb) * __builtin_amdgcn_rcpf(1.0f + ea); }
                        u32x2 wr_, wg; wr_.x = pk2(ra[0], ra[1]); wr_.y = pk2(ra[2], ra[3]); wg.x = pk2(gp[0], gp[1]); wg.y = pk2(gp[2], gp[3]);
                        *(u32x2*)(proj + (size_t)row * NPROJ + C_GS + c) = wr_;
                        *(u32x2*)(proj + (size_t)row * NPROJ + C_GP + c) = wg;
                    } else {
                        u32x4 w; w.x = pk2(v0[0], v0[1]); w.y = pk2(v0[2], v0[3]); w.z = pk2(v1[0], v1[1]); w.w = pk2(v1[2], v1[3]);
                        *(u32x4*)(proj + (size_t)row * NPROJ + col) = w;
                        if (isdt && col < C_DT + 32) { float* d = dtraw + (size_t)row * 32 + (col - C_DT); *(f32x4*)d = v0; *(f32x4*)(d + 4) = v1; } } } }
    }
};
struct EpiMix {
    static constexpr bool MID = false;
    const bf16_t* proj; bf16_t* a2; const float* bias; const float* scale;
    __device__ __forceinline__ void mid(f32x4 (&)[2][2][4][2], const Unit&, int, int, int, int) const {}
    __device__ __forceinline__ void operator()(const f32x4 (&acc)[2][2][4][2], const Unit& u, int wr, int wc, int fr, int fq) const {
        const int row0 = u.pm * BM + wr * 64 + fr, col0 = u.pn * BM + wc * 32 + 8 * fq;
#pragma unroll
        for (int bj = 0; bj < 2; ++bj) { const int col = col0 + bj * HALF;
            const f32x4 b0 = *(const f32x4*)(bias + col), b1 = *(const f32x4*)(bias + col + 4), s0 = *(const f32x4*)(scale + col), s1 = *(const f32x4*)(scale + col + 4);
#pragma unroll
            for (int ai = 0; ai < 2; ++ai)
#pragma unroll
                for (int m = 0; m < 4; ++m) { const int row = row0 + ai * HALF + m * 16;
                    const u32x4 z = __builtin_nontemporal_load((const u32x4*)(proj + (size_t)row * NPROJ + C_ZP + col));
                    f32x4 v0 = (acc[ai][bj][m][0] + b0) * s0, v1 = (acc[ai][bj][m][1] + b1) * s1;
                    v0[0] *= siluf_(bflo(z.x)); v0[1] *= siluf_(bfhi(z.x)); v0[2] *= siluf_(bflo(z.y)); v0[3] *= siluf_(bfhi(z.y));
                    v1[0] *= siluf_(bflo(z.z)); v1[1] *= siluf_(bfhi(z.z)); v1[2] *= siluf_(bflo(z.w)); v1[3] *= siluf_(bfhi(z.w));
                    u32x4 w; w.x = pk2(v0[0], v0[1]); w.y = pk2(v0[2], v0[3]); w.z = pk2(v1[0], v1[1]); w.w = pk2(v1[2], v1[3]);
                    *(u32x4*)(a2 + (size_t)row * 4096 + 2048 + col) = w; } }
    }
};
struct EpiMerged {
    static constexpr bool MID = true;
    const bf16_t* proj; bf16_t* merged;
    __device__ __forceinline__ void mid(f32x4 (&acc)[2][2][4][2], const Unit& u, int wr, int wc, int fr, int fq) const {
        const int row0 = u.pm * BM + wr * 64 + fr, col0 = u.pn * BM + wc * 32 + 8 * fq;
        u32x4 rv[2][4][2];
#pragma unroll
        for (int ai = 0; ai < 2; ++ai)
#pragma unroll
            for (int m = 0; m < 4; ++m) { const bf16_t* rp = proj + (size_t)(row0 + ai * HALF + m * 16) * NPROJ + C_GS + col0; rv[ai][m][0] = __builtin_nontemporal_load((const u32x4*)(rp)); rv[ai][m][1] = __builtin_nontemporal_load((const u32x4*)(rp + HALF)); }
#pragma unroll
        for (int ai = 0; ai < 2; ++ai)
#pragma unroll
            for (int m = 0; m < 4; ++m)
#pragma unroll
                for (int bj = 0; bj < 2; ++bj) { const u32x4 r = rv[ai][m][bj];
                    acc[ai][bj][m][0] *= (f32x4){bflo(r.x), bfhi(r.x), bflo(r.y), bfhi(r.y)}; acc[ai][bj][m][1] *= (f32x4){bflo(r.z), bfhi(r.z), bflo(r.w), bfhi(r.w)}; }
    }
    __device__ __forceinline__ void operator()(const f32x4 (&acc)[2][2][4][2], const Unit& u, int wr, int wc, int fr, int fq) const {
        const int row0 = u.pm * BM + wr * 64 + fr, col0 = u.pn * BM + wc * 32 + 8 * fq;
#pragma unroll
        for (int ai = 0; ai < 2; ++ai)
#pragma unroll
            for (int m = 0; m < 4; ++m) { const int row = row0 + ai * HALF + m * 16;
#pragma unroll
                for (int bj = 0; bj < 2; ++bj) { const int col = col0 + bj * HALF;
                    const u32x4 gp = *(const u32x4*)(proj + (size_t)row * NPROJ + C_GP + col);
                    const f32x4 v0 = acc[ai][bj][m][0], v1 = acc[ai][bj][m][1];
                    u32x4 w; w.x = pk2(v0[0] * bflo(gp.x), v0[1] * bfhi(gp.x)); w.y = pk2(v0[2] * bflo(gp.y), v0[3] * bfhi(gp.y));
                    w.z = pk2(v1[0] * bflo(gp.z), v1[1] * bfhi(gp.z)); w.w = pk2(v1[2] * bflo(gp.w), v1[3] * bfhi(gp.w));
                    *(u32x4*)(merged + (size_t)row * DM + col) = w; } }
    }
};
struct EpiHalf {
    static constexpr bool MID = false;
    const bf16_t* proj; float* F; int which;
    __device__ __forceinline__ void mid(f32x4 (&)[2][2][4][2], const Unit&, int, int, int, int) const {}
    __device__ __forceinline__ void operator()(const f32x4 (&acc)[2][2][4][2], const Unit& u, int wr, int wc, int fr, int fq) const {
        const int row0 = u.pm * BM + wr * 64 + fr, col0 = u.pn * BM + wc * 32 + 8 * fq;
#pragma unroll
        for (int ai = 0; ai < 2; ++ai)
#pragma unroll
            for (int m = 0; m < 4; ++m) { const int row = row0 + ai * HALF + m * 16;
#pragma unroll
                for (int bj = 0; bj < 2; ++bj) { const int col = col0 + bj * HALF;
                    const u32x4 gp = *(const u32x4*)(proj + (size_t)row * NPROJ + C_GP + col);
                    f32x4 f0 = (f32x4){bflo(gp.x), bfhi(gp.x), bflo(gp.y), bfhi(gp.y)}, f1 = (f32x4){bflo(gp.z), bfhi(gp.z), bflo(gp.w), bfhi(gp.w)};
                    if (which == 0) { const u32x4 r = *(const u32x4*)(proj + (size_t)row * NPROJ + C_GS + col);
                        f0 *= (f32x4){bflo(r.x), bfhi(r.x), bflo(r.y), bfhi(r.y)}; f1 *= (f32x4){bflo(r.z), bfhi(r.z), bflo(r.w), bfhi(r.w)}; }
                    float* d = F + (size_t)(row - 8192) * DM + col;
                    *(f32x4*)d = acc[ai][bj][m][0] * f0; *(f32x4*)(d + 4) = acc[ai][bj][m][1] * f1; } }
    }
};
struct EpiOut {
    static constexpr bool MID = false;
    Params p; float* rss;
    __device__ __forceinline__ void mid(f32x4 (&)[2][2][4][2], const Unit&, int, int, int, int) const {}
    __device__ __forceinline__ void operator()(const f32x4 (&acc)[2][2][4][2], const Unit& u, int wr, int wc, int fr, int fq) const {
        const int row0 = u.pm * BM + wr * 64 + fr, col0 = u.pn * BM + wc * 32 + 8 * fq;
#pragma unroll
        for (int ai = 0; ai < 2; ++ai)
#pragma unroll
            for (int m = 0; m < 4; ++m) { const int row = row0 + ai * HALF + m * 16;
                const float* src = row_src(p, row); float* dst = row_dst(p, row); float ss = 0.f;
                if (dst) {
#pragma unroll
                    for (int bj = 0; bj < 2; ++bj) { const int col = col0 + bj * HALF;
                        const f32x4 h0 = __builtin_nontemporal_load((const f32x4*)(src + col)), h1 = __builtin_nontemporal_load((const f32x4*)(src + col + 4));
                        const f32x4 v0 = acc[ai][bj][m][0] + h0, v1 = acc[ai][bj][m][1] + h1;
                        *(f32x4*)(dst + col) = v0; *(f32x4*)(dst + col + 4) = v1;
                        ss += v0[0] * v0[0] + v0[1] * v0[1] + v0[2] * v0[2] + v0[3] * v0[3] + v1[0] * v1[0] + v1[1] * v1[1] + v1[2] * v1[2] + v1[3] * v1[3]; } }
                ss += __shfl_xor(ss, 16); ss += __shfl_xor(ss, 32);
                if (fq == 0) rss[(size_t)row * 32 + u.pn * 4 + wc] = ss; }
    }
};

__device__ __forceinline__ int win_src_col(int n) {
    if (n < 5120) return n;
    if (n < C_GS) return n + 32;
    if (n < C_DT) { const int j = n - C_GS, k = j >> 3, wi = j & 7; return ((wi >> 2) ? 11296 : 9248) + 4 * k + (wi & 3); }
    if (n < C_DT + 32) return n - C_DT + 5120;
    return -1;
}
constexpr int TT_LD = 257;
struct TTile { const float* src; bf16_t* dst; int sld, dld, k0, n0, remap; };
__device__ __forceinline__ TTile tt_get(const Params& p, int it) {
    bf16_t* WINT = (bf16_t*)(p.ws + W_WINT); bf16_t* WSP = (bf16_t*)(p.ws + W_WSP); bf16_t* WMIX = (bf16_t*)(p.ws + W_WMIX); bf16_t* WOUT = (bf16_t*)(p.ws + W_WOUT);
    constexpr int NT_IN = 53 * 32, NT_SQ = 8 * 32;
    TTile t;
    if (it < NT_IN) { t = TTile{p.w_in, WINT, 13344, DM, (it & 31) * 64, (it >> 5) * 256, 1}; }
    else if (it < NT_IN + NT_SQ) { const int j = it - NT_IN; t = TTile{p.w_proj_ssd, WSP, DM, 4096, (j & 31) * 64, (j >> 5) * 256, 0}; }
    else if (it < NT_IN + 2 * NT_SQ) { const int j = it - NT_IN - NT_SQ; t = TTile{p.w_proj_pool, WSP + 2048, DM, 4096, (j & 31) * 64, (j >> 5) * 256, 0}; }
    else if (it < NT_IN + 3 * NT_SQ) { const int j = it - NT_IN - 2 * NT_SQ; t = TTile{p.w_out, WOUT, DM, DM, (j & 31) * 64, (j >> 5) * 256, 0}; }
    else { const int j = it - NT_IN - 3 * NT_SQ, gq = j >> 4, r = j & 15; t = TTile{p.pool_mix_w + (size_t)gq * 512 * 512, WMIX + (size_t)gq * 512 * 512, 512, 512, (r & 7) * 64, (r >> 3) * 256, 0}; }
    return t;
}
constexpr int TT_TOTAL = 53 * 32 + 3 * 8 * 32 + 64;
__device__ __forceinline__ void tt_load(const TTile& t, int tid, f32x4 (&v)[8]) {
    const int c4 = tid & 63, kb = tid >> 6; const int n = t.n0 + 4 * c4; const int sc = t.remap ? win_src_col(n) : n;
#pragma unroll
    for (int ps = 0; ps < 8; ++ps) { const int k = ps * 8 + kb; v[ps] = sc >= 0 ? __builtin_nontemporal_load((const f32x4*)(t.src + (size_t)(t.k0 + k) * t.sld + sc)) : (f32x4){0.f, 0.f, 0.f, 0.f}; }
}
__device__ __forceinline__ void phase_prep(const Params& p, float* tile) {
    const int tid = tid_opaque(), wid = tid >> 6, lane = tid & 63;
    bf16_t* XN = (bf16_t*)(p.ws + W_XN);
    for (int r = blockIdx.x * 8 + wid; r < TROWS; r += gridDim.x * 8) {
        const float* src = row_src(p, r); bf16_t* dst = XN + (size_t)r * DM;
        if (!src) {
#pragma unroll
            for (int i = 0; i < 4; ++i) *(u32x4*)(dst + (lane + 64 * i) * 8) = (u32x4){0u, 0u, 0u, 0u};
        } else {
            f32x4 v[8]; float ss = 0.f;
#pragma unroll
            for (int i = 0; i < 8; ++i) { v[i] = __builtin_nontemporal_load((const f32x4*)src + lane + 64 * i); ss += v[i][0] * v[i][0] + v[i][1] * v[i][1] + v[i][2] * v[i][2] + v[i][3] * v[i][3]; }
#pragma unroll
            for (int o = 32; o >= 1; o >>= 1) ss += __shfl_xor(ss, o);
            const float rs = rsqrtf(ss * (1.0f / DM) + EPS);
#pragma unroll
            for (int i = 0; i < 8; ++i) { const f32x4 w = ((const f32x4*)p.norm_w)[lane + 64 * i];
                u32x2 o; o.x = pk2(v[i][0] * rs * w[0], v[i][1] * rs * w[1]); o.y = pk2(v[i][2] * rs * w[2], v[i][3] * rs * w[3]);
                *(u32x2*)(dst + (lane + 64 * i) * 4) = o; }
        }
    }
    int it = blockIdx.x;
    if (it < TT_TOTAL) {
        TTile cur = tt_get(p, it); f32x4 v[8]; tt_load(cur, tid, v);
        for (;;) {
            { const int c4 = tid & 63, kb = tid >> 6;
#pragma unroll
                for (int ps = 0; ps < 8; ++ps) { float* d = tile + (ps * 8 + kb) * TT_LD + 4 * c4; d[0] = v[ps][0]; d[1] = v[ps][1]; d[2] = v[ps][2]; d[3] = v[ps][3]; } }
            __syncthreads();
            const int nit = it + gridDim.x; const bool more = nit < TT_TOTAL;
            const TTile nxt = tt_get(p, more ? nit : it);
            if (more) tt_load(nxt, tid, v);
            { const int kg = tid & 7, nb = tid >> 3;
#pragma unroll
                for (int i = 0; i < 4; ++i) { const int n = nb + 64 * i; float x[8];
#pragma unroll
                    for (int j = 0; j < 8; ++j) x[j] = tile[(kg * 8 + j) * TT_LD + n];
                    u32x4 w; w.x = pk2(x[0], x[1]); w.y = pk2(x[2], x[3]); w.z = pk2(x[4], x[5]); w.w = pk2(x[6], x[7]);
                    *(u32x4*)(cur.dst + (size_t)(cur.n0 + n) * cur.dld + cur.k0 + kg * 8) = w; } }
            __syncthreads();
            if (!more) break;
            cur = nxt; it = nit;
        }
    }
}

__device__ __forceinline__ void pool_prompt(const Params& p, unsigned char* smem, int b, int rt, int g) {
    const int tid = tid_opaque();
    bf16_t* tile = (bf16_t*)smem;
    const bf16_t* PROJ = (const bf16_t*)(p.ws + W_PROJ);
    bf16_t* POOLED = (bf16_t*)(p.ws + W_XN);
    const int r0 = b * TP + rt * 64;
#pragma unroll
    for (int v = tid; v < 79 * 64; v += 512) { const int k = v >> 6, cv = v & 63; int rr = r0 - 15 + k; rr = rr < 0 ? 0 : rr;
        *(u32x4*)(tile + k * 512 + cv * 8) = __builtin_nontemporal_load((const u32x4*)(PROJ + (size_t)rr * NPROJ + C_U + g * 512 + cv * 8)); }
    __syncthreads();
    const int w = 2 << g, c2 = tid & 255, hf = tid >> 8;
    const unsigned* tile32 = (const unsigned*)tile;
    float s0 = 0.f, s1 = 0.f;
    for (int k = 1; k < w; ++k) { const unsigned x = tile32[(15 + 32 * hf - k) * 256 + c2]; s0 += bflo(x); s1 += bfhi(x); }
#pragma unroll 8
    for (int i = 0; i < 32; ++i) {
        const int ri = 32 * hf + i, tseq = rt * 64 + ri; int cnt = tseq - PADR + 1; cnt = cnt > w ? w : cnt; cnt = cnt < 1 ? 1 : cnt;
        const unsigned cu = tile32[(15 + ri) * 256 + c2]; const float c0 = bflo(cu), c1 = bfhi(cu);
        s0 += c0; s1 += c1;
        const float inv = __builtin_amdgcn_rcpf((float)cnt);
        *(unsigned*)(POOLED + (size_t)(r0 + ri) * DM + g * 512 + 2 * c2) = pk2(s0 * inv - c0, s1 * inv - c1);
        const unsigned ou = tile32[(15 + ri - (w - 1)) * 256 + c2]; s0 -= bflo(ou); s1 -= bfhi(ou);
        if (tseq >= TP - 15) { float* d = p.out + O_PP + ((size_t)b * 15 + (tseq - (TP - 15))) * DM + g * 512 + 2 * c2; d[0] = c0; d[1] = c1; }
    }
    __syncthreads();
}
__device__ __forceinline__ void pool_sample(const Params& p, int s, int g) {
    const int col = g * 512 + tid_opaque(), w = 2 << g;
    const bf16_t* PROJ = (const bf16_t*)(p.ws + W_PROJ);
    bf16_t* POOLED = (bf16_t*)(p.ws + W_XN);
    float v[23];
#pragma unroll
    for (int j = 0; j < 15; ++j) v[j] = p.state_pool[((size_t)s * 15 + j) * DM + col];
#pragma unroll
    for (int t = 0; t < 8; ++t) v[15 + t] = bf2f(PROJ[(size_t)(ROWS_P + s * 8 + t) * NPROJ + C_U + col]);
    const float inv = 1.0f / (float)w;
#pragma unroll
    for (int t = 0; t < 8; ++t) { float sum = 0.f;
#pragma unroll
        for (int k = 0; k < 16; ++k) sum += (k < w) ? v[15 + t - k] : 0.f;
        POOLED[(size_t)(ROWS_P + s * 8 + t) * DM + col] = f2bf(sum * inv - v[15 + t]); }
#pragma unroll
    for (int j = 0; j < 15; ++j) p.out[O_PS + ((size_t)s * 15 + j) * DM + col] = v[j + 8];
}

__device__ __forceinline__ void phase_conv(const Params& p) {
    const bf16_t* PROJ = (const bf16_t*)(p.ws + W_PROJ);
    bf16_t* XACT = (bf16_t*)(p.ws + W_XACT);
    constexpr int NRUN = TROWS / 8, NCG = CONVD / 8, NRUN_P = ROWS_P / 8;
    const int tid = tid_opaque();
    struct Raw { u32x4 L[11]; };
    auto load_raw = [&](int item, Raw& r) {
        const int run = item / NCG, cc = (item - run * NCG) * 8, r0 = run * 8;
        const bool smp = run >= NRUN_P;
#pragma unroll
        for (int k = 0; k < 11; ++k) { int rr = r0 - 3 + k; rr = (rr < 0 || (smp && k < 3)) ? r0 : rr; r.L[k] = __builtin_nontemporal_load((const u32x4*)(PROJ + (size_t)rr * NPROJ + C_XBC + cc)); }
    };
    auto compute = [&](int item, const Raw& r) {
        const int run = item / NCG, cc = (item - run * NCG) * 8, r0 = run * 8;
        const bool smp = run >= NRUN_P; const int s = run - NRUN_P;
        const bool zero0 = (!smp && r0 < 3);
        float hv[3][8];
#pragma unroll
        for (int k = 0; k < 3; ++k) {
            if (smp) { const f32x4 a = *(const f32x4*)(p.state_conv + ((size_t)s * 3 + k) * CONVD + cc), b = *(const f32x4*)(p.state_conv + ((size_t)s * 3 + k) * CONVD + cc + 4);
                hv[k][0] = a[0]; hv[k][1] = a[1]; hv[k][2] = a[2]; hv[k][3] = a[3]; hv[k][4] = b[0]; hv[k][5] = b[1]; hv[k][6] = b[2]; hv[k][7] = b[3]; }
            else { const u32x4 L = r.L[k];
                hv[k][0] = bflo(L.x); hv[k][1] = bfhi(L.x); hv[k][2] = bflo(L.y); hv[k][3] = bfhi(L.y); hv[k][4] = bflo(L.z); hv[k][5] = bfhi(L.z); hv[k][6] = bflo(L.w); hv[k][7] = bfhi(L.w);
                if (zero0) {
#pragma unroll
                    for (int j = 0; j < 8; ++j) hv[k][j] = 0.f; } }
        }
        float w[4][8], bb[8];
#pragma unroll
        for (int k = 0; k < 4; ++k) { const f32x4 a = *(const f32x4*)(p.conv_w + k * CONVD + cc), b = *(const f32x4*)(p.conv_w + k * CONVD + cc + 4);
            w[k][0] = a[0]; w[k][1] = a[1]; w[k][2] = a[2]; w[k][3] = a[3]; w[k][4] = b[0]; w[k][5] = b[1]; w[k][6] = b[2]; w[k][7] = b[3]; }
        { const f32x4 a = *(const f32x4*)(p.conv_b + cc), b = *(const f32x4*)(p.conv_b + cc + 4); bb[0] = a[0]; bb[1] = a[1]; bb[2] = a[2]; bb[3] = a[3]; bb[4] = b[0]; bb[5] = b[1]; bb[6] = b[2]; bb[7] = b[3]; }
#pragma unroll
        for (int i = 0; i < 8; ++i) { float o[8];
#pragma unroll
            for (int j = 0; j < 8; ++j) o[j] = bb[j];
#pragma unroll
            for (int k = 0; k < 4; ++k) { const int rk = i + k;
                float x[8];
                if (rk < 3) {
#pragma unroll
                    for (int j = 0; j < 8; ++j) x[j] = hv[rk][j];
                } else { const u32x4 L = r.L[rk]; x[0] = bflo(L.x); x[1] = bfhi(L.x); x[2] = bflo(L.y); x[3] = bfhi(L.y); x[4] = bflo(L.z); x[5] = bfhi(L.z); x[6] = bflo(L.w); x[7] = bfhi(L.w); }
#pragma unroll
                for (int j = 0; j < 8; ++j) o[j] += x[j] * w[k][j]; }
#pragma unroll
            for (int j = 0; j < 8; ++j) o[j] = siluf_(o[j]);
            u32x4 q; q.x = pk2(o[0], o[1]); q.y = pk2(o[2], o[3]); q.z = pk2(o[4], o[5]); q.w = pk2(o[6], o[7]);
            *(u32x4*)(XACT + (size_t)(r0 + i) * CONVD + cc) = q; }
        float* cst = nullptr;
        if (smp) cst = p.out + O_CS + (size_t)s * 3 * CONVD + cc;
        else if ((run % (TP / 8)) == TP / 8 - 1) cst = p.out + O_CP + (size_t)(run / (TP / 8)) * 3 * CONVD + cc;
        if (cst) {
#pragma unroll
            for (int j = 0; j < 3; ++j) { const u32x4 L = r.L[8 + j];
                *(f32x4*)(cst + j * CONVD) = (f32x4){bflo(L.x), bfhi(L.x), bflo(L.y), bfhi(L.y)}; *(f32x4*)(cst + j * CONVD + 4) = (f32x4){bflo(L.z), bfhi(L.z), bflo(L.w), bfhi(L.w)}; } }
    };
    {
        const int NIT = NRUN * NCG, stride = gridDim.x * 512;
        int item = blockIdx.x * 512 + tid;
        Raw ra, rb;
        if (item < NIT) load_raw(item, ra);
        while (item < NIT) {
            int nxt = item + stride;
            if (nxt < NIT) load_raw(nxt, rb);
            compute(item, ra);
            item = nxt;
            if (item < NIT) { nxt = item + stride; if (nxt < NIT) load_raw(nxt, ra); compute(item, rb); item = nxt; }
        }
    }
    const float* DTR = (const float*)(p.ws + W_DTRAW); float* DT = (float*)(p.ws + W_DT); float* AC = (float*)(p.ws + W_AC);
    { const int wid = tid >> 6, lane = tid & 63;
      for (int it = blockIdx.x * 8 + wid; it < 68 * 32; it += gridDim.x * 8) { const int ch = it >> 5, h = it & 31;
          const size_t r0 = (size_t)ch * 128 + 2 * lane; const int tseq = (ch % 17) * 128 + 2 * lane;
          float d0 = softplusf_(DTR[r0 * 32 + h] + p.dt_bias[h]), d1 = softplusf_(DTR[(r0 + 1) * 32 + h] + p.dt_bias[h]);
          if (tseq < PADR) d0 = 0.f; if (tseq + 1 < PADR) d1 = 0.f;
          const float a = -__expf(p.a_log[h]), v0 = d0 * a, v1 = d1 * a, s = v0 + v1; float incl = s;
#pragma unroll
          for (int o = 1; o < 64; o <<= 1) { const float nb = __shfl_up(incl, o); if (lane >= o) incl += nb; }
          const float excl = incl - s;
          DT[r0 * 32 + h] = d0; DT[(r0 + 1) * 32 + h] = d1; AC[r0 * 32 + h] = excl + v0; AC[(r0 + 1) * 32 + h] = excl + s; } }
    for (int e = ROWS_P * 32 + blockIdx.x * 512 + tid; e < TROWS * 32; e += gridDim.x * 512) DT[e] = softplusf_(DTR[e] + p.dt_bias[e & 31]);
}

typedef short s16x4 __attribute__((ext_vector_type(4)));
constexpr int XROW = 72, LROW = 136;
__device__ __forceinline__ u32x2 tr4(LAS bf16_t* img, int stride, int R0, int col0, int fr) {
    const s16x4 v = __builtin_amdgcn_ds_read_tr16_b64_v4i16((LAS s16x4*)(img + (R0 + (fr >> 2)) * stride + col0 + 4 * (fr & 3)));
    return __builtin_bit_cast(u32x2, v);
}
__device__ __forceinline__ void ssd_prompt(const Params& p, LAS unsigned char* lds, int b, int h) {
    const int tid = tid_opaque(), wid = __builtin_amdgcn_readfirstlane(tid >> 6), lane = tid & 63, fr = lane & 15, fq = lane >> 4;
    const int g = h >> 3;
    LAS bf16_t* sX = (LAS bf16_t*)(lds);
    LAS bf16_t* sB = (LAS bf16_t*)(lds + 18432);
    LAS bf16_t* sC = (LAS bf16_t*)(lds + 53248);
    LAS bf16_t* sH = (LAS bf16_t*)(lds + 88064);
    LAS float* sDt = (LAS float*)(lds + 105472);
    LAS float* sAc = sDt + 128;
    LAS float* sW = sAc + 128;
    const bf16_t* PROJ = (const bf16_t*)(p.ws + W_PROJ);
    const bf16_t* XACT = (const bf16_t*)(p.ws + W_XACT);
    const float* DT = (const float*)(p.ws + W_DT);
    const float* AC = (const float*)(p.ws + W_AC);
    bf16_t* A2 = (bf16_t*)(p.ws + W_A2);
    float* YSS = (float*)(p.ws + W_YSS);
    const float Dh = p.d_skip[h];
    for (int i = tid; i < 64 * LROW / 2; i += 512) ((LAS unsigned*)sH)[i] = 0u;
    f32x4 hacc[4];
#pragma unroll
    for (int i = 0; i < 4; ++i) hacc[i] = (f32x4){0.f, 0.f, 0.f, 0.f};
    const int trow = 16 * wid + fr;
    u32x4 rx[2], rb[4], rc[4]; u32x2 rz[4]; float rd0 = 0.f, rd1 = 0.f, ra0 = 0.f, ra1 = 0.f;
#define SSD_ISSUE(cn) do { const size_t nb_ = (size_t)b * TP + (size_t)(cn) * 128; \
        _Pragma("unroll") for (int i = 0; i < 2; ++i) { const int v_ = tid + 512 * i; rx[i] = *(const u32x4*)(XACT + (nb_ + (v_ >> 3)) * CONVD + h * 64 + (v_ & 7) * 8); } \
        _Pragma("unroll") for (int i = 0; i < 4; ++i) { const int v_ = tid + 512 * i; const bf16_t* q_ = XACT + (nb_ + (v_ >> 4)) * CONVD + 2048 + g * 128 + (v_ & 15) * 8; rb[i] = *(const u32x4*)q_; rc[i] = *(const u32x4*)(q_ + 512); } \
        if (wid == 0) { rd0 = DT[(nb_ + 2 * lane) * 32 + h]; rd1 = DT[(nb_ + 2 * lane + 1) * 32 + h]; ra0 = AC[(nb_ + 2 * lane) * 32 + h]; ra1 = AC[(nb_ + 2 * lane + 1) * 32 + h]; } } while (0)
#define SSD_ISSUE_Z(cn) do { const bf16_t* q_ = PROJ + ((size_t)b * TP + (size_t)(cn) * 128 + trow) * NPROJ + C_Z + h * 64 + 4 * fq; \
        _Pragma("unroll") for (int pt = 0; pt < 4; ++pt) rz[pt] = *(const u32x2*)(q_ + 16 * pt); } while (0)
    SSD_ISSUE(0); SSD_ISSUE_Z(0);
    for (int c = 0; c < 17; ++c) {
        const int base = b * TP + c * 128;
        if (wid == 0) { const int t0 = 2 * lane; sDt[t0] = rd0; sDt[t0 + 1] = rd1; sAc[t0] = ra0; sAc[t0 + 1] = ra1; }
#pragma unroll
        for (int i = 0; i < 2; ++i) { const int v_ = tid + 512 * i; *(LAS u32x4*)(sX + (v_ >> 3) * XROW + (v_ & 7) * 8) = rx[i]; }
#pragma unroll
        for (int i = 0; i < 4; ++i) { const int v_ = tid + 512 * i; *(LAS u32x4*)(sB + (v_ >> 4) * LROW + (v_ & 15) * 8) = rb[i]; *(LAS u32x4*)(sC + (v_ >> 4) * LROW + (v_ & 15) * 8) = rc[i]; }
        __syncthreads();
        const int cn = c < 16 ? c + 1 : 16;
        SSD_ISSUE(cn);
        if (tid < 128) sW[tid] = __expf(sAc[127] - sAc[tid]) * sDt[tid];
        const float act = sAc[trow];
        bf16x8 cf[4];
#pragma unroll
        for (int kk = 0; kk < 4; ++kk) cf[kk] = *(const LAS bf16x8*)(sC + trow * LROW + 32 * kk + 8 * fq);
        f32x4 d[8];
#pragma unroll
        for (int st = 0; st < 8; ++st) d[st] = (f32x4){0.f, 0.f, 0.f, 0.f};
#pragma unroll
        for (int kk = 0; kk < 4; ++kk) {
            bf16x8 bfr[8];
#pragma unroll
            for (int st = 0; st < 8; ++st) bfr[st] = *(const LAS bf16x8*)(sB + (16 * st + fr) * LROW + 32 * kk + 8 * fq);
#pragma unroll
            for (int st = 0; st < 8; ++st) d[st] = __builtin_amdgcn_mfma_f32_16x16x32_bf16(bfr[st], cf[kk], d[st], 0, 0, 0);
        }
        bf16x8 gfrag[4];
        {
#pragma unroll
            for (int kb = 0; kb < 4; ++kb) {
                f32x4 acs[2], dts[2];
#pragma unroll
                for (int hf = 0; hf < 2; ++hf) { acs[hf] = *(const LAS f32x4*)(sAc + 16 * (2 * kb + hf) + 4 * fq); dts[hf] = *(const LAS f32x4*)(sDt + 16 * (2 * kb + hf) + 4 * fq); }
                unsigned pkd[4];
#pragma unroll
                for (int hf = 0; hf < 2; ++hf) { const int st = 2 * kb + hf; float gv[4];
#pragma unroll
                    for (int jj = 0; jj < 4; ++jj) { const int s = 16 * st + 4 * fq + jj; gv[jj] = (s <= trow) ? d[st][jj] * __expf(act - acs[hf][jj]) * dts[hf][jj] : 0.f; }
                    pkd[2 * hf] = pk2(gv[0], gv[1]); pkd[2 * hf + 1] = pk2(gv[2], gv[3]); }
                u32x4 w; w.x = pkd[0]; w.y = pkd[1]; w.z = pkd[2]; w.w = pkd[3];
                gfrag[kb] = __builtin_bit_cast(bf16x8, w);
            }
        }
        const float eact = __expf(act);
        const int grow = base + trow;
        f32x4 y[4];
#pragma unroll
        for (int pt = 0; pt < 4; ++pt) y[pt] = (f32x4){0.f, 0.f, 0.f, 0.f};
#pragma unroll
        for (int kk = 0; kk < 4; ++kk) {
            bf16x8 hf[4];
#pragma unroll
            for (int pt = 0; pt < 4; ++pt) hf[pt] = *(const LAS bf16x8*)(sH + (16 * pt + fr) * LROW + 32 * kk + 8 * fq);
#pragma unroll
            for (int pt = 0; pt < 4; ++pt) y[pt] = __builtin_amdgcn_mfma_f32_16x16x32_bf16(hf[pt], cf[kk], y[pt], 0, 0, 0);
        }
#pragma unroll
        for (int pt = 0; pt < 4; ++pt) y[pt] *= eact;
#pragma unroll
        for (int kb = 0; kb < 4; ++kb) {
            u32x2 x0[4], x1[4];
#pragma unroll
            for (int pt = 0; pt < 4; ++pt) { x0[pt] = tr4(sX, XROW, 32 * kb + 4 * fq, 16 * pt, fr); x1[pt] = tr4(sX, XROW, 32 * kb + 16 + 4 * fq, 16 * pt, fr); }
#pragma unroll
            for (int pt = 0; pt < 4; ++pt) { u32x4 w; w.x = x0[pt].x; w.y = x0[pt].y; w.z = x1[pt].x; w.w = x1[pt].y;
                y[pt] = __builtin_amdgcn_mfma_f32_16x16x32_bf16(__builtin_bit_cast(bf16x8, w), gfrag[kb], y[pt], 0, 0, 0); }
        }
        float ssq = 0.f;
        {
            u32x2 xx[4];
#pragma unroll
            for (int pt = 0; pt < 4; ++pt) xx[pt] = *(const LAS u32x2*)(sX + trow * XROW + 16 * pt + 4 * fq);
#pragma unroll
            for (int pt = 0; pt < 4; ++pt) {
                const int pc = 16 * pt + 4 * fq;
                const float zf[4] = {bflo(rz[pt].x), bfhi(rz[pt].x), bflo(rz[pt].y), bfhi(rz[pt].y)};
                const float xf[4] = {bflo(xx[pt].x), bfhi(xx[pt].x), bflo(xx[pt].y), bfhi(xx[pt].y)};
                float yo[4];
#pragma unroll
                for (int jj = 0; jj < 4; ++jj) { const float v = (y[pt][jj] + Dh * xf[jj]) * siluf_(zf[jj]); yo[jj] = v; ssq += v * v; }
                u32x2 w; w.x = pk2(yo[0], yo[1]); w.y = pk2(yo[2], yo[3]);
                *(u32x2*)(A2 + (size_t)grow * 4096 + h * 64 + pc) = w;
            }
        }
        ssq += __shfl_xor(ssq, 16); ssq += __shfl_xor(ssq, 32);
        if (fq == 0) YSS[(size_t)grow * 32 + h] = ssq;
        SSD_ISSUE_Z(cn);
        __syncthreads();
        {
            const float dec = __expf(sAc[127]);
            const int ptile = wid & 3, nt0 = (wid >> 2) * 4;
#pragma unroll
            for (int i = 0; i < 4; ++i) hacc[i] *= dec;
#pragma unroll
            for (int kk = 0; kk < 4; ++kk) {
                const int sb = 32 * kk + 8 * fq;
                const u32x2 xlo = tr4(sX, XROW, sb, 16 * ptile, fr), xhi = tr4(sX, XROW, sb + 4, 16 * ptile, fr);
                const f32x4 w0 = *(const LAS f32x4*)(sW + sb), w1 = *(const LAS f32x4*)(sW + sb + 4);
                u32x2 blo[4], bhi[4];
#pragma unroll
                for (int i = 0; i < 4; ++i) { blo[i] = tr4(sB, LROW, sb, 16 * (nt0 + i), fr); bhi[i] = tr4(sB, LROW, sb + 4, 16 * (nt0 + i), fr); }
                u32x4 w;
                w.x = pk2(bflo(xlo.x) * w0[0], bfhi(xlo.x) * w0[1]); w.y = pk2(bflo(xlo.y) * w0[2], bfhi(xlo.y) * w0[3]);
                w.z = pk2(bflo(xhi.x) * w1[0], bfhi(xhi.x) * w1[1]); w.w = pk2(bflo(xhi.y) * w1[2], bfhi(xhi.y) * w1[3]);
                const bf16x8 xa = __builtin_bit_cast(bf16x8, w);
#pragma unroll
                for (int i = 0; i < 4; ++i) { u32x4 bw; bw.x = blo[i].x; bw.y = blo[i].y; bw.z = bhi[i].x; bw.w = bhi[i].y;
                    hacc[i] = __builtin_amdgcn_mfma_f32_16x16x32_bf16(xa, __builtin_bit_cast(bf16x8, bw), hacc[i], 0, 0, 0); }
            }
#pragma unroll
            for (int i = 0; i < 4; ++i)
#pragma unroll
                for (int jj = 0; jj < 4; ++jj) sH[(16 * ptile + 4 * fq + jj) * LROW + 16 * (nt0 + i) + fr] = f2bf(hacc[i][jj]);
        }
        __syncthreads();
    }
#undef SSD_ISSUE
#undef SSD_ISSUE_Z
    { const int ptile = wid & 3, nt0 = (wid >> 2) * 4; float* dst = p.out + O_SP + ((size_t)(b * 32 + h) * 64) * 128;
#pragma unroll
        for (int i = 0; i < 4; ++i)
#pragma unroll
            for (int jj = 0; jj < 4; ++jj) dst[(16 * ptile + 4 * fq + jj) * 128 + 16 * (nt0 + i) + fr] = hacc[i][jj]; }
}

__device__ __forceinline__ void ssd_sample(const Params& p, LAS unsigned char* lds, int s, int g) {
    const int tid = tid_opaque(), wid = __builtin_amdgcn_readfirstlane(tid >> 6), lane = tid & 63, fr = lane & 15, fq = lane >> 4;
    LAS bf16_t* sXT = (LAS bf16_t*)(lds);
    LAS bf16_t* sBT = (LAS bf16_t*)(lds + 8192);
    LAS bf16_t* sBn = (LAS bf16_t*)(lds + 10240);
    LAS bf16_t* sCn = (LAS bf16_t*)(lds + 12288);
    LAS float* sCB = (LAS float*)(lds + 14336);
    LAS float* sDt2 = sCB + 64;
    LAS float* sAc2 = sDt2 + 64;
    const bf16_t* PROJ = (const bf16_t*)(p.ws + W_PROJ);
    const bf16_t* XACT = (const bf16_t*)(p.ws + W_XACT);
    const float* DT = (const float*)(p.ws + W_DT);
    bf16_t* A2 = (bf16_t*)(p.ws + W_A2);
    float* YSS = (float*)(p.ws + W_YSS);
    const int rbase = ROWS_P + s * 8;
    const int h = g * 8 + wid;
    const float* hsrc = p.state_ssm + ((size_t)s * 32 + h) * 8192 + (size_t)fr * 128 + 4 * fq;
    float* hdst = p.out + O_SS + ((size_t)s * 32 + h) * 8192 + (size_t)fr * 128 + 4 * fq;
    f32x4 ha[8], hb[8];
#define SMP_LOADH(dst, pt) do { _Pragma("unroll") for (int nt = 0; nt < 8; ++nt) dst[nt] = __builtin_nontemporal_load((const f32x4*)(hsrc + (pt) * 2048 + nt * 16)); } while (0)
    SMP_LOADH(ha, 0);
    float zv[4][4];
#pragma unroll
    for (int jj = 0; jj < 4; ++jj)
#pragma unroll
        for (int pt = 0; pt < 4; ++pt) zv[jj][pt] = bf2f(PROJ[(size_t)(rbase + ((4 * fq + jj) & 7)) * NPROJ + C_Z + h * 64 + 16 * pt + fr]);
    __builtin_amdgcn_sched_barrier(0);
    { const int row = tid >> 6, cgx = tid & 63; const u32x4 L = *(const u32x4*)(XACT + (size_t)(rbase + row) * CONVD + g * 512 + cgx * 8);
        LAS bf16_t* d = sXT + (cgx * 8) * 8 + row;
        d[0] = (bf16_t)(L.x & 0xffffu); d[8] = (bf16_t)(L.x >> 16); d[16] = (bf16_t)(L.y & 0xffffu); d[24] = (bf16_t)(L.y >> 16);
        d[32] = (bf16_t)(L.z & 0xffffu); d[40] = (bf16_t)(L.z >> 16); d[48] = (bf16_t)(L.w & 0xffffu); d[56] = (bf16_t)(L.w >> 16); }
    if (tid < 256) { const int which = tid >> 7, v = tid & 127, row = v >> 4, cg = v & 15;
        const u32x4 L = *(const u32x4*)(XACT + (size_t)(rbase + row) * CONVD + 2048 + which * 512 + g * 128 + cg * 8);
        *(LAS u32x4*)((which ? sCn : sBn) + row * 128 + cg * 8) = L;
        if (which == 0) { LAS bf16_t* d = sBT + (cg * 8) * 8 + row;
            d[0] = (bf16_t)(L.x & 0xffffu); d[8] = (bf16_t)(L.x >> 16); d[16] = (bf16_t)(L.y & 0xffffu); d[24] = (bf16_t)(L.y >> 16);
            d[32] = (bf16_t)(L.z & 0xffffu); d[40] = (bf16_t)(L.z >> 16); d[48] = (bf16_t)(L.w & 0xffffu); d[56] = (bf16_t)(L.w >> 16); } }
    else if (tid < 320) { const int l = tid - 256, hh = l >> 3, t = l & 7, h2 = g * 8 + hh;
        const float dt = DT[(size_t)(rbase + t) * 32 + h2];
        float v = dt * (-__expf(p.a_log[h2]));
#pragma unroll
        for (int o = 1; o < 8; o <<= 1) { const float nb = __shfl_up(v, o, 8); if (t >= o) v += nb; }
        sDt2[l] = dt; sAc2[l] = v; }
    __syncthreads();
    { const int pair = tid >> 3, part = tid & 7, t = pair >> 3, s2 = pair & 7; float d = 0.f;
        const u32x4 c0 = *(const LAS u32x4*)(sCn + t * 128 + 16 * part), c1 = *(const LAS u32x4*)(sCn + t * 128 + 16 * part + 8);
        const u32x4 b0 = *(const LAS u32x4*)(sBn + s2 * 128 + 16 * part), b1 = *(const LAS u32x4*)(sBn + s2 * 128 + 16 * part + 8);
        d += bflo(c0.x) * bflo(b0.x) + bfhi(c0.x) * bfhi(b0.x) + bflo(c0.y) * bflo(b0.y) + bfhi(c0.y) * bfhi(b0.y) + bflo(c0.z) * bflo(b0.z) + bfhi(c0.z) * bfhi(b0.z) + bflo(c0.w) * bflo(b0.w) + bfhi(c0.w) * bfhi(b0.w);
        d += bflo(c1.x) * bflo(b1.x) + bfhi(c1.x) * bfhi(b1.x) + bflo(c1.y) * bflo(b1.y) + bfhi(c1.y) * bfhi(b1.y) + bflo(c1.z) * bflo(b1.z) + bfhi(c1.z) * bfhi(b1.z) + bflo(c1.w) * bflo(b1.w) + bfhi(c1.w) * bfhi(b1.w);
        d += __shfl_xor(d, 1); d += __shfl_xor(d, 2); d += __shfl_xor(d, 4);
        if (part == 0) sCB[pair] = d; }
    __syncthreads();
    const int tl = fr & 7;
    float ac[8], dtv[8];
    { const f32x4 a0 = *(const LAS f32x4*)(sAc2 + wid * 8), a1 = *(const LAS f32x4*)(sAc2 + wid * 8 + 4), d0 = *(const LAS f32x4*)(sDt2 + wid * 8), d1 = *(const LAS f32x4*)(sDt2 + wid * 8 + 4);
#pragma unroll
      for (int t = 0; t < 4; ++t) { ac[t] = a0[t]; ac[4 + t] = a1[t]; dtv[t] = d0[t]; dtv[4 + t] = d1[t]; } }
    const float aT = ac[7], dec = __expf(aT), Dh = p.d_skip[h];
    float wv[8];
#pragma unroll
    for (int s2 = 0; s2 < 8; ++s2) wv[s2] = __expf(aT - ac[s2]) * dtv[s2];
    bf16x8 gfrag;
    { float actl = ac[0];
#pragma unroll
      for (int k = 1; k < 8; ++k) actl = (tl == k) ? ac[k] : actl;
      const f32x4 cb0 = *(const LAS f32x4*)(sCB + tl * 8), cb1 = *(const LAS f32x4*)(sCB + tl * 8 + 4);
      float gv[8];
#pragma unroll
      for (int s2 = 0; s2 < 8; ++s2) { const float cbv = s2 < 4 ? cb0[s2 & 3] : cb1[s2 & 3]; gv[s2] = (s2 <= tl && fq == 0) ? cbv * __expf(fminf(actl - ac[s2], 0.f)) * dtv[s2] : 0.f; }
      u32x4 w; w.x = pk2(gv[0], gv[1]); w.y = pk2(gv[2], gv[3]); w.z = pk2(gv[4], gv[5]); w.w = pk2(gv[6], gv[7]); gfrag = __builtin_bit_cast(bf16x8, w); }
    bf16x8 cfrag[4];
#pragma unroll
    for (int kk = 0; kk < 4; ++kk) { const u32x2 lo = *(const LAS u32x2*)(sCn + tl * 128 + 32 * kk + 4 * fq), hi = *(const LAS u32x2*)(sCn + tl * 128 + 32 * kk + 16 + 4 * fq);
        u32x4 w; w.x = lo.x; w.y = lo.y; w.z = hi.x; w.w = hi.y; cfrag[kk] = __builtin_bit_cast(bf16x8, w); }
    bf16x8 btf[8];
#pragma unroll
    for (int nt = 0; nt < 8; ++nt) { u32x4 w = *(const LAS u32x4*)(sBT + (16 * nt + fr) * 8); if (fq != 0) w = (u32x4){0u, 0u, 0u, 0u}; btf[nt] = __builtin_bit_cast(bf16x8, w); }
    float eact[4];
#pragma unroll
    for (int jj = 0; jj < 4; ++jj) { float a_ = ac[0];
#pragma unroll
        for (int k = 1; k < 8; ++k) a_ = (((4 * fq + jj) & 7) == k) ? ac[k] : a_;
        eact[jj] = __expf(a_); }
    float ssq[4] = {0.f, 0.f, 0.f, 0.f};
    auto ptile = [&](const f32x4 (&hv)[8], int pt) {
        const u32x4 xr = *(const LAS u32x4*)(sXT + (wid * 64 + 16 * pt + fr) * 8);
        const float xf[8] = {bflo(xr.x), bfhi(xr.x), bflo(xr.y), bfhi(xr.y), bflo(xr.z), bfhi(xr.z), bflo(xr.w), bfhi(xr.w)};
        f32x4 y = (f32x4){0.f, 0.f, 0.f, 0.f};
#pragma unroll
        for (int kk = 0; kk < 4; ++kk) { u32x4 w; w.x = pk2(hv[2 * kk][0], hv[2 * kk][1]); w.y = pk2(hv[2 * kk][2], hv[2 * kk][3]); w.z = pk2(hv[2 * kk + 1][0], hv[2 * kk + 1][1]); w.w = pk2(hv[2 * kk + 1][2], hv[2 * kk + 1][3]);
            y = __builtin_amdgcn_mfma_f32_16x16x32_bf16(cfrag[kk], __builtin_bit_cast(bf16x8, w), y, 0, 0, 0); }
#pragma unroll
        for (int jj = 0; jj < 4; ++jj) y[jj] *= eact[jj];
        { u32x4 w = fq == 0 ? xr : (u32x4){0u, 0u, 0u, 0u}; y = __builtin_amdgcn_mfma_f32_16x16x32_bf16(gfrag, __builtin_bit_cast(bf16x8, w), y, 0, 0, 0); }
        if (fq < 2) {
            float xt[4];
#pragma unroll
            for (int jj = 0; jj < 4; ++jj) xt[jj] = fq == 0 ? xf[jj] : xf[4 + jj];
#pragma unroll
            for (int jj = 0; jj < 4; ++jj) { const float v = (y[jj] + Dh * xt[jj]) * siluf_(zv[jj][pt]); ssq[jj] += v * v;
                A2[(size_t)(rbase + 4 * fq + jj) * 4096 + h * 64 + 16 * pt + fr] = f2bf(v); }
        }
        u32x4 xw; xw.x = pk2(xf[0] * wv[0], xf[1] * wv[1]); xw.y = pk2(xf[2] * wv[2], xf[3] * wv[3]); xw.z = pk2(xf[4] * wv[4], xf[5] * wv[5]); xw.w = pk2(xf[6] * wv[6], xf[7] * wv[7]);
        if (fq != 0) xw = (u32x4){0u, 0u, 0u, 0u};
        const bf16x8 xwf = __builtin_bit_cast(bf16x8, xw);
#pragma unroll
        for (int nt = 0; nt < 8; ++nt) { f32x4 acc = hv[nt] * dec; acc = __builtin_amdgcn_mfma_f32_16x16x32_bf16(btf[nt], xwf, acc, 0, 0, 0);
            __builtin_nontemporal_store(acc, (f32x4*)(hdst + pt * 2048 + nt * 16)); }
    };
    SMP_LOADH(hb, 1); __builtin_amdgcn_sched_barrier(0);
    ptile(ha, 0); SMP_LOADH(ha, 2); __builtin_amdgcn_sched_barrier(0);
    ptile(hb, 1); SMP_LOADH(hb, 3); __builtin_amdgcn_sched_barrier(0);
    ptile(ha, 2); __builtin_amdgcn_sched_barrier(0);
    ptile(hb, 3);
#undef SMP_LOADH
#pragma unroll
    for (int jj = 0; jj < 4; ++jj) { float v = ssq[jj]; v += __shfl_xor(v, 1); v += __shfl_xor(v, 2); v += __shfl_xor(v, 4); v += __shfl_xor(v, 8); ssq[jj] = v; }
    if (fr == 0 && fq < 2) {
#pragma unroll
        for (int jj = 0; jj < 4; ++jj) YSS[(size_t)(rbase + 4 * fq + jj) * 32 + h] = ssq[jj]; }
    __syncthreads();
}
__device__ __forceinline__ void phase_elem(const Params& p, unsigned char* smem) {
    phase_conv(p);
    for (int it = blockIdx.x; it < 544 + 512; it += gridDim.x) {
        if (it < 544) pool_prompt(p, smem, it / 136, (it % 136) >> 2, it & 3);
        else { const int j = it - 544; pool_sample(p, j >> 2, j & 3); }
    }
}
__device__ __forceinline__ void phase_ssd(const Params& p, unsigned char* smem) {
    const int G = gridDim.x, bid = blockIdx.x;
    if (bid < 128) {
        const int xcd = bid & 7, slot = bid >> 3, pair = xcd * 2 + (slot >> 3);
        ssd_prompt(p, (LAS unsigned char*)smem, pair >> 2, (pair & 3) * 8 + (slot & 7)); }
    else for (int it = bid - 128; it < 512; it += G - 128) ssd_sample(p, (LAS unsigned char*)smem, it >> 2, it & 3);
}

__device__ __forceinline__ void phase_ynorm(const Params& p, int vbid, int vG) {
    const int tid = tid_opaque(); const int wid = tid >> 6, lane = tid & 63;
    bf16_t* A2 = (bf16_t*)(p.ws + W_A2); const float* YSS = (const float*)(p.ws + W_YSS);
    for (int it = vbid * 8 + wid; it < TROWS * 4; it += vG * 8) {
        const int row = it >> 2, g = it & 3;
        const f32x4 s0 = *(const f32x4*)(YSS + (size_t)row * 32 + g * 8), s1 = *(const f32x4*)(YSS + (size_t)row * 32 + g * 8 + 4);
        const float ss = s0[0] + s0[1] + s0[2] + s0[3] + s1[0] + s1[1] + s1[2] + s1[3];
        const float rs = rsqrtf(ss * (1.0f / 512.0f) + EPS);
        bf16_t* ptr = A2 + (size_t)row * 4096 + g * 512 + lane * 8;
        const u32x4 v = *(const u32x4*)ptr;
        const f32x4 w0 = *(const f32x4*)(p.ssd_norm_w + g * 512 + lane * 8), w1 = *(const f32x4*)(p.ssd_norm_w + g * 512 + lane * 8 + 4);
        u32x4 o; o.x = pk2(bflo(v.x) * rs * w0[0], bfhi(v.x) * rs * w0[1]); o.y = pk2(bflo(v.y) * rs * w0[2], bfhi(v.y) * rs * w0[3]);
        o.z = pk2(bflo(v.z) * rs * w1[0], bfhi(v.z) * rs * w1[1]); o.w = pk2(bflo(v.w) * rs * w1[2], bfhi(v.w) * rs * w1[3]);
        *(u32x4*)ptr = o;
    }
}
__device__ __forceinline__ void phase_final(const Params& p, int rb, int re, int vbid, int vG) {
    const int tid = tid_opaque(); const int wid = tid >> 6, lane = tid & 63;
    const float* RSS = (const float*)(p.ws + W_RSS);
    for (int r = rb + vbid * 8 + wid; r < re; r += vG * 8) {
        float* dst = row_dst(p, r); if (!dst) continue;
        float ss = lane < 32 ? RSS[(size_t)r * 32 + lane] : 0.f;
#pragma unroll
        for (int o = 32; o >= 1; o >>= 1) ss += __shfl_xor(ss, o);
        const float rs = rsqrtf(ss * (1.0f / DM) + EPS);
#pragma unroll
        for (int i = 0; i < 8; ++i) { f32x4 v = ((f32x4*)dst)[lane + 64 * i]; const f32x4 w = ((const f32x4*)p.final_norm_w)[lane + 64 * i];
            v[0] *= rs * w[0]; v[1] *= rs * w[1]; v[2] *= rs * w[2]; v[3] *= rs * w[3]; ((f32x4*)dst)[lane + 64 * i] = v; }
    }
}


#define XB_TMO      128
#define XB_XCNT(j)  (256  + 64 * (j))
#define XB_XSUB(j)  (1280 + 64 * (j))
#define XB_XGEN(j)  (2304 + 64 * (j))
#define XB_TOP      3328
#define XB_TOPGEN   3392
#define XCD_BAR_WORDS 3456
#define XB_SPIN_CAP (1u << 18)
__device__ __forceinline__ unsigned xb_ld(unsigned* p)              { return __hip_atomic_load(p, __ATOMIC_RELAXED, __HIP_MEMORY_SCOPE_AGENT); }
__device__ __forceinline__ unsigned xb_add(unsigned* p, unsigned v) { return __hip_atomic_fetch_add(p, v, __ATOMIC_RELAXED, __HIP_MEMORY_SCOPE_AGENT); }
__device__ __forceinline__ unsigned xb_xcc_id() { return (unsigned)__builtin_amdgcn_s_getreg((3 << 11) | 20) & 0xFu; }
#define XB_SPIN(cond, bar) do { unsigned _sp = 0; while (cond) { __builtin_amdgcn_s_sleep(1); \
    if ((++_sp & 255u) == 0u) { if (xb_ld(&(bar)[XB_TMO])) break; if (_sp > XB_SPIN_CAP) { atomicAdd(&(bar)[XB_TMO], 1u); break; } } } } while (0)
struct XcdBarrier { unsigned* bar; unsigned x; volatile LAS unsigned* st; };
__device__ __forceinline__ XcdBarrier xcd_barrier_post(unsigned* bar, volatile LAS unsigned* st) {
    XcdBarrier b; b.bar = bar; b.x = xb_xcc_id(); b.st = st;
    if (threadIdx.x == 0) (void)xb_add(&bar[XB_XCNT(b.x)], 1u);
    return b;
}
__device__ __forceinline__ void xcd_barrier_complete(unsigned* bar, unsigned x, unsigned& nloc, unsigned& nx) {
    const unsigned G = gridDim.x * gridDim.y * gridDim.z;
    unsigned sum, cnt, mine, sp = 0u;
    for (;;) {
        sum = 0u; cnt = 0u; mine = 0u;
#pragma unroll
        for (unsigned j = 0; j < 16; ++j) { const unsigned c = xb_ld(&bar[XB_XCNT(j)]); sum += c; cnt += (c > 0u) ? 1u : 0u; mine = (j == x) ? c : mine; }
        if (sum == G) break;
        __builtin_amdgcn_s_sleep(1);
        if ((++sp & 255u) == 0u) { if (xb_ld(&bar[XB_TMO])) break; if (sp > XB_SPIN_CAP) { atomicAdd(&bar[XB_TMO], 1u); break; } }
    }
    nloc = mine > 0u ? mine : 1u; nx = cnt > 0u ? cnt : 1u;
}
__device__ __forceinline__ void xcd_barrier(const XcdBarrier& b) {
    asm volatile("s_waitcnt vmcnt(0)" ::: "memory");
    __syncthreads();
    if (threadIdx.x == 0) {
        unsigned* bar = b.bar;
        __builtin_amdgcn_s_waitcnt(0);
        unsigned nloc = b.st[0], nx = b.st[1];
        if (nloc == 0u) { xcd_barrier_complete(bar, b.x, nloc, nx); b.st[0] = nloc; b.st[1] = nx; }
        const unsigned old = xb_add(&bar[XB_XSUB(b.x)], 1u);
        const unsigned gen = old / nloc;
        if (old + 1u == (gen + 1u) * nloc) {
            __builtin_amdgcn_fence(__ATOMIC_RELEASE, "agent");
            asm volatile("s_waitcnt vmcnt(0)" ::: "memory");
            const unsigned og = xb_add(&bar[XB_TOP], 1u);
            const unsigned tg = og / nx;
            if (og + 1u == (tg + 1u) * nx) xb_add(&bar[XB_TOPGEN], 1u);
            else XB_SPIN(xb_ld(&bar[XB_TOPGEN]) == tg, bar);
            __builtin_amdgcn_fence(__ATOMIC_ACQUIRE, "agent");
            xb_add(&bar[XB_XGEN(b.x)], 1u);
            asm volatile("s_waitcnt vmcnt(0)" ::: "memory");
        } else {
            XB_SPIN(xb_ld(&bar[XB_XGEN(b.x)]) == gen, bar);
            __builtin_amdgcn_fence(__ATOMIC_ACQUIRE, "agent");
            asm volatile("s_waitcnt vmcnt(0)" ::: "memory");
        }
    }
    __syncthreads();
}

__global__ void __launch_bounds__(512, 2) fwd_megakernel(Params p) {
    extern __shared__ __attribute__((aligned(16))) unsigned char shm[];
    cg::grid_group grid = cg::this_grid();
    LAS unsigned char* lds = (LAS unsigned char*)shm;
    bf16_t* XN = (bf16_t*)(p.ws + W_XN); bf16_t* PROJ = (bf16_t*)(p.ws + W_PROJ); bf16_t* A2 = (bf16_t*)(p.ws + W_A2);
    volatile LAS unsigned* xst = (volatile LAS unsigned*)(lds + LDS_BYTES - 16);
    if (threadIdx.x == 0) { xst[0] = 0u; xst[1] = 0u; }
    __syncthreads();
    if (blockIdx.x == 0 && threadIdx.x < 64) {
        unsigned* bw = (unsigned*)(p.ws + W_BAR);
        for (int i = threadIdx.x; i < 4096; i += 64) __hip_atomic_store(bw + i, 0u, __ATOMIC_RELAXED, __HIP_MEMORY_SCOPE_AGENT);
        asm volatile("s_waitcnt vmcnt(0)" ::: "memory");
        __builtin_amdgcn_fence(__ATOMIC_RELEASE, "agent");
        asm volatile("s_waitcnt vmcnt(0)" ::: "memory");
    }
    grid.sync();
    const XcdBarrier xb = xcd_barrier_post((unsigned*)(p.ws + W_BAR), xst);
    phase_prep(p, (float*)shm);
    xcd_barrier(xb);
    { GemmD g{XN, (const bf16_t*)(p.ws + W_WINT), DM, DM, DM, TROWS / BM, NPROJ / BM, 0, 0, 1, 0, (int)blockIdx.x, (int)gridDim.x, 0, (TROWS / BM) * (NPROJ / BM), 0};
      EpiProj e{PROJ, (float*)(p.ws + W_DTRAW)};
      gemm_phase(lds, g, e); }
    xcd_barrier(xb);
    phase_elem(p, shm);
    xcd_barrier(xb);
    phase_ssd(p, shm);
    xcd_barrier(xb);
    { GemmD g{XN  , (const bf16_t*)(p.ws + W_WMIX), DM, 512, 512, TROWS / BM, DM / BM, 2, 512, 1, 0, (int)blockIdx.x, (int)gridDim.x, 0, (TROWS / BM) * (DM / BM), 0};
      EpiMix e{PROJ, A2, p.pool_mix_b, p.pool_scale};
      gemm_phase(lds, g, e); }
    if (blockIdx.x >= 48) phase_ynorm(p, blockIdx.x - 48, gridDim.x - 48);
    xcd_barrier(xb);
#pragma unroll 1
    for (int stage = 0; stage < 3; ++stage) {
        const int bid = blockIdx.x;
        float* Fh = (float*)(p.ws + W_XACT);
        if (stage == 0) {
            GemmD g{A2, (const bf16_t*)(p.ws + W_WSP), 4096, 4096, 2048, 32, DM / BM, 0, 0, 2, 0, bid, 256, 0, 256, 0};
            EpiMerged e{PROJ, XN  };
            gemm_phase(lds, g, e);
        } else if (stage == 1 && bid < 96) {
            const int which = bid >= 48 ? 1 : 0;
            GemmD g{A2 + which * 2048, (const bf16_t*)(p.ws + W_WSP) + which * 2048, 4096, 4096, 2048, 6, DM / BM, 0, 0, 1, 32, bid - 48 * which, 48, 0, 48, 0};
            EpiHalf e{PROJ, Fh + (size_t)which * 1536 * DM, which};
            gemm_phase(lds, g, e);
        } else if (stage == 1 || bid < 144) {
            const bool tailp = (stage == 2 && bid >= 96);
            GemmD g{XN  , (const bf16_t*)(p.ws + W_WOUT), DM, DM, DM, tailp ? 6 : 32, DM / BM, 0, 0, 1, tailp ? 32 : 0,
                    stage == 1 ? bid - 96 : (tailp ? bid - 96 : bid), stage == 1 ? 160 : (tailp ? 48 : 96), (stage == 2 && !tailp) ? 160 : 0, stage == 1 ? 160 : (tailp ? 48 : 256), tailp ? 0 : 1};
            EpiOut e{p, (float*)(p.ws + W_RSS)};
            gemm_phase(lds, g, e);
        } else if (stage == 2) {
            phase_final(p, 0, 5120, bid - 144, 112);
        }
        xcd_barrier(xb);
        if (stage == 1) {
            const int tid = tid_opaque();
            for (int i = bid * 512 + tid; i < 1536 * DM / 8; i += 256 * 512) {
                const f32x4 a0 = *(const f32x4*)(Fh + (size_t)i * 8), a1 = *(const f32x4*)(Fh + (size_t)i * 8 + 4), b0 = *(const f32x4*)(Fh + (size_t)1536 * DM + (size_t)i * 8), b1 = *(const f32x4*)(Fh + (size_t)1536 * DM + (size_t)i * 8 + 4);
                u32x4 w; w.x = pk2(a0[0] + b0[0], a0[1] + b0[1]); w.y = pk2(a0[2] + b0[2], a0[3] + b0[3]); w.z = pk2(a1[0] + b1[0], a1[1] + b1[1]); w.w = pk2(a1[2] + b1[2], a1[3] + b1[3]);
                *(u32x4*)(XN + (size_t)8192 * DM + (size_t)i * 8) = w; }
            xcd_barrier(xb);
        }
    }
    phase_final(p, 5120, TROWS, blockIdx.x, gridDim.x);
}

extern "C" void kernel_launch(void* const* d_in, const int* in_sizes, int n_in, void* d_out, int out_size, void* d_ws, size_t ws_size, hipStream_t stream) {
    static int grid_blocks = 0;
    if (!grid_blocks) {
        int dev = 0, cus = 0, per_cu = 0;
        hipGetDevice(&dev);
        hipDeviceGetAttribute(&cus, hipDeviceAttributeMultiprocessorCount, dev);
        hipFuncSetAttribute((const void*)fwd_megakernel, hipFuncAttributeMaxDynamicSharedMemorySize, LDS_BYTES);
        hipOccupancyMaxActiveBlocksPerMultiprocessor(&per_cu, fwd_megakernel, 512, LDS_BYTES);
        if (per_cu > 1) per_cu = 1;
        grid_blocks = cus * per_cu;
        grid_blocks &= ~7;
        if (grid_blocks != 256) { fprintf(stderr, "this kernel's static schedule needs exactly 256 resident workgroups (got %d)\n", grid_blocks); grid_blocks = -1; }
    }
    if (ws_size < W_END || grid_blocks <= 0) { fprintf(stderr, "workspace too small or no occupancy (%zu, %d)\n", ws_size, grid_blocks); return; }
    Params p{};
    const float** f = (const float**)&p;
    for (int i = 0; i < 21; ++i) f[i] = (const float*)d_in[i];
    p.out = (float*)d_out; p.ws = (unsigned char*)d_ws;
    void* args[] = {&p};
    hipError_t e = hipLaunchCooperativeKernel((void*)fwd_megakernel, dim3(grid_blocks), dim3(512), args, LDS_BYTES, stream);
    if (e != hipSuccess) fprintf(stderr, "cooperative launch failed: %s (grid %d)\n", hipGetErrorString(e), grid_blocks);
}
```
